# Optimizing an MI355X kernel written in HIP

```python
import math
import jax, jax.numpy as jnp
from jax import lax
import numpy as np

D_MODEL = 1024
BATCH = 8
SEQ = 2048
DEPTH = 2

HEAD_DIM = 64
MOBA_HEADS = (D_MODEL // 2) // HEAD_DIM
MOBA_WIDTH = MOBA_HEADS * HEAD_DIM
DIFF_HEADS = (D_MODEL // 2) // (2 * HEAD_DIM)
DIFF_V_DIM = 2 * HEAD_DIM
DIFF_WIDTH = DIFF_HEADS * DIFF_V_DIM
MIX_WIDTH = MOBA_WIDTH + DIFF_WIDTH
IN_WIDTH = 3 * MOBA_WIDTH + 3 * DIFF_WIDTH
MOBA_BLOCK = 256
MOBA_TOPK = 3
MOBA_Q_CHUNK = 64
DENSE_Q_BLOCK = 128
ROPE_THETA = 500000.0
ROPE_DIM = HEAD_DIM // 4
D_FF = -(-(8 * D_MODEL) // (3 * 256)) * 256
N_MOD = 6
EPS = 1e-6

kernel_name = 'hybrid_moba_diffattn_adaln_block'


def rms_norm(x, g):
    xf = x.astype(jnp.float32)
    y = xf * lax.rsqrt(jnp.mean(xf * xf, axis=-1, keepdims=True) + EPS)
    return (y * g.astype(jnp.float32)).astype(x.dtype)


def rope_tables(positions):
    inv = ROPE_THETA ** (-jnp.arange(0, ROPE_DIM, 2, dtype=jnp.float32) / ROPE_DIM)
    ang = positions.astype(jnp.float32)[..., None] * inv
    return jnp.cos(ang)[:, None], jnp.sin(ang)[:, None]


def apply_partial_rope(x, cos, sin):
    half = ROPE_DIM // 2
    xf = x.astype(jnp.float32)
    x1 = xf[..., :half]
    x2 = xf[..., half:ROPE_DIM]
    out = jnp.concatenate([x1 * cos - x2 * sin, x2 * cos + x1 * sin, xf[..., ROPE_DIM:]], axis=-1)
    return out.astype(x.dtype)


def moba_attention(q, k, v):
    B, H, S, dh = q.shape
    nb = -(-S // MOBA_BLOCK)
    pad = nb * MOBA_BLOCK - S
    kp = jnp.pad(k, ((0, 0), (0, 0), (0, pad), (0, 0)))
    vp = jnp.pad(v, ((0, 0), (0, 0), (0, pad), (0, 0)))
    kb = kp.reshape(B, H, nb, MOBA_BLOCK, dh)
    vb = vp.reshape(B, H, nb, MOBA_BLOCK, dh)
    k_mean = jnp.mean(kb.astype(jnp.float32), axis=3)
    topk = min(MOBA_TOPK, nb)
    n_chunks = S // MOBA_Q_CHUNK
    scale = dh ** -0.5
    b_ids = jnp.repeat(jnp.arange(B, dtype=jnp.int32), n_chunks)
    c_ids = jnp.tile(jnp.arange(n_chunks, dtype=jnp.int32), B)
    h_ids = jnp.arange(H)[:, None, None]
    blk_ids = jnp.arange(nb)

    def one_chunk(args):
        b, ci = args
        q0 = ci * MOBA_Q_CHUNK
        qblk = q0 // MOBA_BLOCK
        qpos = q0 + jnp.arange(MOBA_Q_CHUNK)
        qc = lax.dynamic_slice_in_dim(q[b], q0, MOBA_Q_CHUNK, axis=1)
        gate = jnp.einsum('hqd,hnd->hqn', qc.astype(jnp.float32), k_mean[b])
        gate = jnp.where(blk_ids < qblk, gate, -jnp.inf)
        _, idx = lax.top_k(gate, topk)
        sel_valid = idx < qblk
        k_sel = kb[b][h_ids, idx]
        v_sel = vb[b][h_ids, idx]
        s_sel = jnp.einsum('hqd,hqjkd->hqjk', qc, k_sel).astype(jnp.float32) * scale
        s_sel = jnp.where(sel_valid[..., None], s_sel, -jnp.inf)
        k_own = lax.dynamic_slice_in_dim(kp[b], qblk * MOBA_BLOCK, MOBA_BLOCK, axis=1)
        v_own = lax.dynamic_slice_in_dim(vp[b], qblk * MOBA_BLOCK, MOBA_BLOCK, axis=1)
        s_own = jnp.einsum('hqd,hkd->hqk', qc, k_own).astype(jnp.float32) * scale
        kpos = qblk * MOBA_BLOCK + jnp.arange(MOBA_BLOCK)
        s_own = jnp.where(kpos[None, :] <= qpos[:, None], s_own, -jnp.inf)
        s = jnp.concatenate([s_sel.reshape(H, MOBA_Q_CHUNK, topk * MOBA_BLOCK), s_own], axis=-1)
        p = jax.nn.softmax(s, axis=-1).astype(v.dtype)
        p_sel = p[..., :topk * MOBA_BLOCK].reshape(H, MOBA_Q_CHUNK, topk, MOBA_BLOCK)
        p_own = p[..., topk * MOBA_BLOCK:]
        return (jnp.einsum('hqjk,hqjkd->hqd', p_sel, v_sel)
                + jnp.einsum('hqk,hkd->hqd', p_own, v_own))

    out = lax.map(one_chunk, (b_ids, c_ids))
    out = out.reshape(B, n_chunks, H, MOBA_Q_CHUNK, dh).transpose(0, 2, 1, 3, 4)
    return out.reshape(B, H, S, dh)


def diff_attention(q, k, v, lam):
    B, H, _, S, dh = q.shape
    n_qb = S // DENSE_Q_BLOCK
    scale = dh ** -0.5
    kpos = jnp.arange(S)

    def one_block(ci):
        q0 = ci * DENSE_Q_BLOCK
        qc = lax.dynamic_slice_in_dim(q, q0, DENSE_Q_BLOCK, axis=3)
        s = jnp.einsum('bhcqd,bhckd->bhcqk', qc, k).astype(jnp.float32) * scale
        qpos = q0 + jnp.arange(DENSE_Q_BLOCK)
        s = jnp.where(kpos[None, :] <= qpos[:, None], s, -jnp.inf)
        a = jax.nn.softmax(s, axis=-1)
        w = (a[:, :, 0] - lam * a[:, :, 1]).astype(v.dtype)
        return jnp.einsum('bhqk,bhkd->bhqd', w, v)

    out = lax.map(one_block, jnp.arange(n_qb, dtype=jnp.int32))
    return out.transpose(1, 2, 0, 3, 4).reshape(B, H, S, v.shape[-1])


def setup_inputs(seed: int = 0) -> dict:
    key = jax.random.key(seed)
    ks = jax.random.split(key, 20)
    f32 = jnp.float32
    L = DEPTH

    def nrm(k, shape, scale):
        return jax.random.normal(k, shape, f32) * scale

    def gain(k, shape):
        return 1.0 + 0.02 * jax.random.normal(k, shape, f32)

    return {
        'x': nrm(ks[0], (BATCH, SEQ, D_MODEL), 1.0),
        'c': nrm(ks[1], (BATCH, D_MODEL), 1.0),
        'positions': jnp.broadcast_to(jnp.arange(SEQ, dtype=jnp.int32)[None, :], (BATCH, SEQ)),
        'w_mod': nrm(ks[2], (L, D_MODEL, N_MOD * D_MODEL), 0.5 * D_MODEL ** -0.5),
        'b_mod': nrm(ks[3], (L, N_MOD * D_MODEL), 0.01),
        'norm_mix': gain(ks[4], (L, D_MODEL)),
        'w_in': nrm(ks[5], (L, D_MODEL, IN_WIDTH), D_MODEL ** -0.5),
        'moba_q_norm': gain(ks[6], (L, HEAD_DIM)),
        'moba_k_norm': gain(ks[7], (L, HEAD_DIM)),
        'moba_out_norm': gain(ks[8], (L, HEAD_DIM)),
        'diff_q_norm': gain(ks[9], (L, HEAD_DIM)),
        'diff_k_norm': gain(ks[10], (L, HEAD_DIM)),
        'diff_lambda': nrm(ks[11], (L, 4, HEAD_DIM), 0.1),
        'diff_subln': gain(ks[12], (L, DIFF_V_DIM)),
        'w_out': nrm(ks[13], (L, MIX_WIDTH, D_MODEL), MIX_WIDTH ** -0.5),
        'norm_ffn': gain(ks[14], (L, D_MODEL)),
        'w_gate': nrm(ks[15], (L, D_MODEL, D_FF), D_MODEL ** -0.5),
        'w_up': nrm(ks[16], (L, D_MODEL, D_FF), D_MODEL ** -0.5),
        'w_down': nrm(ks[17], (L, D_FF, D_MODEL), D_FF ** -0.5),
    }


def reference(x, c, positions, w_mod, b_mod, norm_mix, w_in, moba_q_norm, moba_k_norm,
              moba_out_norm, diff_q_norm, diff_k_norm, diff_lambda, diff_subln, w_out,
              norm_ffn, w_gate, w_up, w_down):
    B, S, _ = x.shape
    cos, sin = rope_tables(positions)
    cond = jax.nn.silu(c)
    splits = [MOBA_WIDTH, 2 * MOBA_WIDTH, 3 * MOBA_WIDTH,
              3 * MOBA_WIDTH + DIFF_WIDTH, 3 * MOBA_WIDTH + 2 * DIFF_WIDTH]

    def heads(t, n, d):
        return t.reshape(B, S, n, d).transpose(0, 2, 1, 3)

    for l in range(DEPTH):
        mod = (cond @ w_mod[l] + b_mod[l])[:, None, :]
        sh_a, sc_a, g_a, sh_f, sc_f, g_f = jnp.split(mod, N_MOD, axis=-1)

        h = rms_norm(x, norm_mix[l]) * (1 + sc_a) + sh_a
        proj = h @ w_in[l]
        mq, mk, mv, dq, dk, dv = jnp.split(proj, splits, axis=-1)

        mq = apply_partial_rope(rms_norm(heads(mq, MOBA_HEADS, HEAD_DIM), moba_q_norm[l]), cos, sin)
        mk = apply_partial_rope(rms_norm(heads(mk, MOBA_HEADS, HEAD_DIM), moba_k_norm[l]), cos, sin)
        mv = heads(mv, MOBA_HEADS, HEAD_DIM)
        o_m = rms_norm(moba_attention(mq, mk, mv), moba_out_norm[l])
        o_m = o_m.transpose(0, 2, 1, 3).reshape(B, S, MOBA_WIDTH)

        dq = apply_partial_rope(rms_norm(heads(dq, 2 * DIFF_HEADS, HEAD_DIM), diff_q_norm[l]), cos, sin)
        dk = apply_partial_rope(rms_norm(heads(dk, 2 * DIFF_HEADS, HEAD_DIM), diff_k_norm[l]), cos, sin)
        dq = dq.reshape(B, DIFF_HEADS, 2, S, HEAD_DIM)
        dk = dk.reshape(B, DIFF_HEADS, 2, S, HEAD_DIM)
        dv = heads(dv, DIFF_HEADS, DIFF_V_DIM)
        lam_init = 0.8 - 0.6 * math.exp(-0.3 * l)
        lp = diff_lambda[l].astype(jnp.float32)
        lam = jnp.exp(jnp.sum(lp[0] * lp[1])) - jnp.exp(jnp.sum(lp[2] * lp[3])) + lam_init
        o_d = rms_norm(diff_attention(dq, dk, dv, lam), diff_subln[l]) * (1.0 - lam_init)
        o_d = o_d.transpose(0, 2, 1, 3).reshape(B, S, DIFF_WIDTH)

        x = x + g_a * (jnp.concatenate([o_m, o_d], axis=-1) @ w_out[l])

        h = rms_norm(x, norm_ffn[l]) * (1 + sc_f) + sh_f
        x = x + g_f * ((jax.nn.silu(h @ w_gate[l]) * (h @ w_up[l])) @ w_down[l])
    return x
```

```cpp
#include <hip/hip_runtime.h>
#include <hip/hip_cooperative_groups.h>
#include <cstdio>
#include <cstdint>
namespace cg = cooperative_groups;
namespace pg8 {
#define PG8_LAS __attribute__((address_space(3)))
typedef unsigned short bf16_t;
typedef short bf16x8 __attribute__((ext_vector_type(8)));
typedef float f32x4 __attribute__((ext_vector_type(4)));
typedef unsigned u32x4 __attribute__((ext_vector_type(4)));
constexpr int BM = 256, BK = 64, HALF = 128, HTB = HALF * BK * 2  , STAGE_BYTES = 8 * HTB, NXCD = 8, WGM = 8;

__host__ __device__ __forceinline__ int lds_byte(int r, int c) { const int st = (r >> 4) * 2 + (c >> 5), rr = r & 15, cc = c & 31, ob = rr * 64 + cc * 2; return st * 1024 + (ob ^ (((ob >> 9) & 1) << 5)); }
__host__ __device__ __forceinline__ void stage_rc(int b, int& R, int& C) { const int st = b / 1024, sb = b % 1024, swz = sb ^ (((sb >> 9) & 1) << 5); R = (st >> 1) * 16 + swz / 64; C = (st & 1) * 32 + (swz % 64) / 2; }
__host__ __device__ __forceinline__ int perm32(int rho) { const int n = rho >> 4, i = rho & 15; return 8 * (i >> 2) + 4 * n + (i & 3); }

struct Unit { int pm, pn; };
struct Gemm { const bf16_t* A; const bf16_t* Bt; int M, N, K; };

struct StaticOrder {
    int nM, nN, nwg, G, c;
    __host__ __device__ void init(int M, int N, int G_, int c_) { nM = M / BM; nN = N / BM; nwg = nM * nN; G = G_; c = c_; }
    __host__ __device__ bool next(int i, Unit& u) const {
        const long L = (long)i * G + c; if (L >= nwg) return false;
        int wgid = (int)L; { const int q = nwg / NXCD, r = nwg % NXCD, xcd = wgid % NXCD, off = wgid / NXCD; wgid = (xcd < r ? xcd * (q + 1) : r * (q + 1) + (xcd - r) * q) + off; }
        const int nig = WGM * nN, gid = wgid / nig, fm = gid * WGM, gsz = (nM - fm) < WGM ? (nM - fm) : WGM;
        u.pm = fm + ((wgid % nig) % gsz); u.pn = (wgid % nig) / gsz; return true;
    }
    __device__ __forceinline__ void a_ready(const Unit&) const {}
    __device__ __forceinline__ void done(const Unit&) const {}
};
__device__ __forceinline__ unsigned cvt_pk_bf16(float lo, float hi) { unsigned r; asm volatile("v_cvt_pk_bf16_f32 %0, %1, %2" : "=v"(r) : "v"(lo), "v"(hi)); return r; }
typedef float f32x2 __attribute__((ext_vector_type(2)));
template <class Epi, class Sched, bool ALIGN_EPI = false, bool SP2 = false>
__device__ __forceinline__ void gemm_phase(PG8_LAS unsigned char* lds, const Gemm g, const Sched& S, const Epi& E) {
    int tid = threadIdx.x; asm volatile("" : "+v"(tid));
    const int wid = __builtin_amdgcn_readfirstlane(tid >> 6), lane = tid & 63, wr = wid >> 2, wc = wid & 3, fr = lane & 15, fq = lane >> 4;
    const int K = g.K, nt = K / BK;
    unsigned voffA[2], voffB[2];
#pragma unroll
    for (int i = 0; i < 2; ++i) { int R, C; stage_rc(tid * 16 + i * 8192, R, C); const int Rb = Epi::PERM ? ((R & ~31) + perm32(R & 31)) : R;
        voffA[i] = (unsigned)(R * K + C) * 2u; voffB[i] = (unsigned)(Rb * K + C) * 2u; }
    const size_t kstep = (size_t)(BK * 2);
    const size_t hstep = (size_t)HALF * K * 2;
    const size_t tstep = 2 * hstep;
    const unsigned ldsw = (unsigned)wid * 1024u;
    const int aoff = lds_byte(wr * 64 + fr, fq * 8), boff = lds_byte(wc * 32 + fr, fq * 8);
#define PG8_SA(b, h) (((b) * 2 + (h)) * HTB)
#define PG8_SB(b, h) ((4 + (b) * 2 + (h)) * HTB)
#define PG8_STAGE(bufoff, gbase, voff) do { _Pragma("unroll") for (int _i = 0; _i < 2; ++_i) \
        __builtin_amdgcn_global_load_lds((const unsigned*)((const char*)(gbase) + (voff)[_i]), (PG8_LAS unsigned*)(lds + (bufoff) + ldsw + _i * 8192), 16, 0, 0); } while (0)
#define PG8_LDA(dst, b, h) do { _Pragma("unroll") for (int m = 0; m < 4; ++m) _Pragma("unroll") for (int k = 0; k < 2; ++k) dst[m][k] = *(const PG8_LAS bf16x8*)(lds + PG8_SA(b, h) + aoff + m * 2048 + k * 1024); } while (0)
#define PG8_LDB(dst, b, h) do { _Pragma("unroll") for (int n = 0; n < 2; ++n) _Pragma("unroll") for (int k = 0; k < 2; ++k) dst[n][k] = *(const PG8_LAS bf16x8*)(lds + PG8_SB(b, h) + boff + n * 2048 + k * 1024); } while (0)
#define PG8_MMA(ai, bj, At, Bt) do { __builtin_amdgcn_s_setprio(1); _Pragma("unroll") for (int m = 0; m < 4; ++m) _Pragma("unroll") for (int n = 0; n < 2; ++n) _Pragma("unroll") for (int k = 0; k < 2; ++k) \
        acc[ai][bj][m][n] = __builtin_amdgcn_mfma_f32_16x16x32_bf16(Bt[n][k], At[m][k], acc[ai][bj][m][n], 0, 0, 0); __builtin_amdgcn_s_setprio(0); } while (0)
#define PG8_WAIT_V(n) asm volatile("s_waitcnt vmcnt(" #n ")" ::: "memory")
#define PG8_WAIT_L(n) asm volatile("s_waitcnt lgkmcnt(" #n ")" ::: "memory")
#define PG8_BAR __builtin_amdgcn_s_barrier()
#define PG8_SCHED __builtin_amdgcn_sched_barrier(0)
    Unit cur, nxt; int ui = 0;
    if (!S.next(0, cur)) return;
    f32x4 acc[2][2][4][2];
#pragma unroll
    for (int a = 0; a < 2; ++a)
#pragma unroll
        for (int b = 0; b < 2; ++b)
#pragma unroll
            for (int m = 0; m < 4; ++m)
#pragma unroll
                for (int n = 0; n < 2; ++n) acc[a][b][m][n] = (f32x4){0.f, 0.f, 0.f, 0.f};
    bf16x8 At[4][2], B0[2][2], B1[2][2];
    const char* cA = (const char*)g.A + (size_t)cur.pm * tstep; const char* cB = (const char*)g.Bt + (size_t)cur.pn * tstep;
    S.a_ready(cur);
    if constexpr (SP2) {
        PG8_STAGE(PG8_SB(0, 0), cB, voffB); PG8_STAGE(PG8_SB(0, 1), cB + hstep, voffB); PG8_STAGE(PG8_SA(0, 0), cA, voffA); PG8_STAGE(PG8_SA(0, 1), cA + hstep, voffA);
        if (wr == 1) PG8_BAR;
        PG8_WAIT_V(2); PG8_BAR;
        PG8_STAGE(PG8_SB(1, 0), cB + kstep, voffB); PG8_STAGE(PG8_SA(1, 0), cA + kstep, voffA); PG8_STAGE(PG8_SB(1, 1), cB + hstep + kstep, voffB);
        PG8_WAIT_V(6); PG8_BAR;
    } else {
        PG8_STAGE(PG8_SB(0, 0), cB, voffB); PG8_STAGE(PG8_SA(0, 0), cA, voffA); PG8_STAGE(PG8_SB(0, 1), cB + hstep, voffB); PG8_STAGE(PG8_SA(0, 1), cA + hstep, voffA);
        if (wr == 1) PG8_BAR;
        PG8_WAIT_V(4); PG8_BAR;
        PG8_STAGE(PG8_SB(1, 0), cB + kstep, voffB); PG8_STAGE(PG8_SA(1, 0), cA + kstep, voffA); PG8_STAGE(PG8_SB(1, 1), cB + hstep + kstep, voffB);
        PG8_WAIT_V(6); PG8_BAR;
    }
    for (;;) {
        const bool has_next = S.next(ui + 1, nxt);
        const char* nA = has_next ? (const char*)g.A + (size_t)nxt.pm * tstep : cA; const char* nB = has_next ? (const char*)g.Bt + (size_t)nxt.pn * tstep : cB;
        for (int t = 0; t < nt; t += 2) {
            const bool last = (t == nt - 2);
            const char* a1 = cA + (size_t)(t + 1) * kstep;
            const char* a2 = last ? nA : cA + (size_t)(t + 2) * kstep; const char* b2 = last ? nB : cB + (size_t)(t + 2) * kstep;
            const char* a3 = a2 + kstep; const char* b3 = b2 + kstep;
            if (last && has_next) S.a_ready(nxt);
            if constexpr (SP2) {
            PG8_LDB(B0, 0, 0); PG8_LDB(B1, 0, 1); PG8_SCHED; PG8_LDA(At, 0, 0); PG8_STAGE(PG8_SA(1, 1), a1 + hstep, voffA);
            PG8_WAIT_V(8); PG8_WAIT_L(0); PG8_BAR; PG8_MMA(0, 0, At, B0); PG8_MMA(0, 1, At, B1); PG8_BAR; PG8_SCHED;
            PG8_LDA(At, 0, 1); PG8_STAGE(PG8_SB(0, 0), b2, voffB); PG8_STAGE(PG8_SB(0, 1), b2 + hstep, voffB); PG8_STAGE(PG8_SA(0, 0), a2, voffA);
            PG8_WAIT_V(8); PG8_WAIT_L(0); PG8_BAR; PG8_MMA(1, 0, At, B0); PG8_MMA(1, 1, At, B1); PG8_BAR; PG8_SCHED;
            PG8_LDB(B0, 1, 0); PG8_LDB(B1, 1, 1); PG8_SCHED; PG8_LDA(At, 1, 0); PG8_STAGE(PG8_SA(0, 1), a2 + hstep, voffA);
            PG8_WAIT_V(8); PG8_WAIT_L(0); PG8_BAR; PG8_MMA(0, 0, At, B0); PG8_MMA(0, 1, At, B1); PG8_BAR; PG8_SCHED;
            PG8_LDA(At, 1, 1); PG8_STAGE(PG8_SB(1, 0), b3, voffB); PG8_STAGE(PG8_SB(1, 1), b3 + hstep, voffB); PG8_STAGE(PG8_SA(1, 0), a3, voffA);
            PG8_WAIT_V(8); PG8_WAIT_L(0); PG8_BAR; PG8_MMA(1, 0, At, B0); PG8_MMA(1, 1, At, B1); PG8_BAR; PG8_SCHED;
            } else {
            PG8_LDB(B0, 0, 0); PG8_SCHED; PG8_LDA(At, 0, 0); PG8_STAGE(PG8_SA(1, 1), a1 + hstep, voffA);
            PG8_WAIT_L(8); PG8_BAR; PG8_WAIT_L(0); PG8_MMA(0, 0, At, B0); PG8_BAR; PG8_SCHED;
            PG8_LDB(B1, 0, 1); PG8_STAGE(PG8_SB(0, 0), b2, voffB);
            PG8_BAR; PG8_WAIT_L(0); PG8_MMA(0, 1, At, B1); PG8_BAR;
            PG8_LDA(At, 0, 1); PG8_STAGE(PG8_SA(0, 0), a2, voffA);
            PG8_BAR; PG8_WAIT_L(0); PG8_MMA(1, 0, At, B0); PG8_BAR; PG8_SCHED;
            PG8_STAGE(PG8_SB(0, 1), b2 + hstep, voffB);
            PG8_WAIT_V(6); PG8_BAR; PG8_MMA(1, 1, At, B1); PG8_BAR;
            PG8_LDB(B0, 1, 0); PG8_SCHED; PG8_LDA(At, 1, 0); PG8_STAGE(PG8_SA(0, 1), a2 + hstep, voffA);
            PG8_WAIT_L(8); PG8_BAR; PG8_WAIT_L(0); PG8_MMA(0, 0, At, B0); PG8_BAR; PG8_SCHED;
            PG8_LDB(B1, 1, 1); PG8_STAGE(PG8_SB(1, 0), b3, voffB);
            PG8_BAR; PG8_WAIT_L(0); PG8_MMA(0, 1, At, B1); PG8_BAR;
            PG8_LDA(At, 1, 1); PG8_STAGE(PG8_SA(1, 0), a3, voffA);
            PG8_BAR; PG8_WAIT_L(0); PG8_MMA(1, 0, At, B0); PG8_BAR; PG8_SCHED;
            PG8_STAGE(PG8_SB(1, 1), b3 + hstep, voffB);
            PG8_WAIT_V(6); PG8_BAR; PG8_MMA(1, 1, At, B1); PG8_BAR;
            }
        }
        if constexpr (ALIGN_EPI) { if (wr == 0) PG8_BAR; }
        if constexpr (!Epi::AFTER_DRAIN) { E(acc, cur, wr, wc, fr, fq); S.done(cur); }
        if (!has_next) break;
#pragma unroll
        for (int a = 0; a < 2; ++a)
#pragma unroll
            for (int b = 0; b < 2; ++b)
#pragma unroll
                for (int m = 0; m < 4; ++m)
#pragma unroll
                    for (int n = 0; n < 2; ++n) acc[a][b][m][n] = (f32x4){0.f, 0.f, 0.f, 0.f};
        cur = nxt; cA = nA; cB = nB; ++ui;
        if constexpr (ALIGN_EPI) { if (wr == 1) PG8_BAR; }
    }
    PG8_WAIT_V(0);
    if constexpr (!ALIGN_EPI) { if (wr == 0) PG8_BAR; }
    PG8_BAR;
    if constexpr (Epi::AFTER_DRAIN) { E.fused(acc, cur, wr, wc, fr, fq, lds, wid, lane); S.done(cur); }
#undef PG8_SA
#undef PG8_SB
#undef PG8_STAGE
#undef PG8_LDA
#undef PG8_LDB
#undef PG8_MMA
#undef PG8_WAIT_V
#undef PG8_WAIT_L
#undef PG8_BAR
#undef PG8_SCHED
}
}

#define LAS __attribute__((address_space(3)))
using pg8::f32x4; using pg8::u32x4; using pg8::bf16_t; using pg8::bf16x8; using pg8::Unit; using pg8::cvt_pk_bf16;
typedef float f32x16 __attribute__((ext_vector_type(16)));
typedef short s16x4 __attribute__((ext_vector_type(4)));
typedef unsigned u32x2 __attribute__((ext_vector_type(2)));
constexpr int NB = 8, SEQ = 2048, DM = 1024, MT = NB * SEQ, NIN = 3072, DFF = 2816, NGU = 2 * DFF, NMOD = 6 * DM;
constexpr float EPSN = 1e-6f;
constexpr float C2 = 0.125f * 1.4426950408889634f;
constexpr size_t MiB = 1u << 20;
constexpr size_t CTL_ZERO_BYTES = 1 * MiB, CTL_KMEAN = 65536;
constexpr size_t WS_GAINS = 1 * MiB + 393216, WS_MOD = 1 * MiB, WS_ROPE = 1 * MiB + 512 * 1024, WS_PART = 3 * MiB, WS_W = 10 * MiB;
constexpr size_t W_LSTRIDE = 24 * MiB + 512 * 1024, W_IN = 0, W_OUT = 6 * MiB, W_GU = 8 * MiB, W_DN = 19 * MiB;
constexpr size_t WS_XN = 60 * MiB, WS_O = 92 * MiB, WS_QKV = 124 * MiB, WS_H = 124 * MiB, WS_END = 220 * MiB;
constexpr size_t QKV_RS = (size_t)NB * 8 * SEQ * 64;
constexpr int LDS_BYTES = 147456, LDS_MISC = 131072;

__device__ __forceinline__ unsigned f2bf(float f) { unsigned u = __builtin_bit_cast(unsigned, f); return (u + 0x7fffu + ((u >> 16) & 1u)) >> 16; }
__device__ __forceinline__ unsigned pk2(float lo, float hi) { return f2bf(lo) | (f2bf(hi) << 16); }
__device__ __forceinline__ float bf2f(short s) { return __uint_as_float(((unsigned)(unsigned short)s) << 16); }
__device__ __forceinline__ float wave_sum(float v) {
#pragma unroll
    for (int o = 1; o < 64; o <<= 1) v += __shfl_xor(v, o);
    return v;
}

struct EpiQKV {
    static constexpr bool PERM = true, AFTER_DRAIN = false;
    bf16_t* qkv; const float* gains; const float* rope; float* kmean;
    __device__ __forceinline__ void operator()(const f32x4 (&acc)[2][2][4][2], const Unit& u, int wr, int wc, int fr, int fq) const {
        asm volatile("" : "+v"(fr), "+v"(fq));
        const int region = u.pn >> 1, head = (u.pn & 1) * 4 + wc, b = u.pm >> 3;
        const bool isnorm = (region != 2) && (region != 5);
        const float* gp = gains + 64 * (isnorm ? (region - (region > 2 ? 1 : 0)) : 0);
        f32x4 gv[2][2];
#pragma unroll
        for (int bj = 0; bj < 2; ++bj)
#pragma unroll
            for (int n = 0; n < 2; ++n) gv[bj][n] = *(const f32x4*)(gp + 16 * fq + 8 * bj + 4 * n);
        const float qs = (region == 0 || region == 3) ? C2 : 1.f;
        f32x4 ks[2][2];
#pragma unroll
        for (int bj = 0; bj < 2; ++bj)
#pragma unroll
            for (int n = 0; n < 2; ++n) ks[bj][n] = (f32x4){0.f, 0.f, 0.f, 0.f};
        bf16_t* base = qkv + (size_t)region * QKV_RS + ((size_t)(b * 8 + head) * SEQ) * 64 + 16 * fq;
#pragma unroll
        for (int ai = 0; ai < 2; ++ai)
#pragma unroll
            for (int m = 0; m < 4; ++m) {
                const int row = u.pm * 256 + ai * 128 + wr * 64 + m * 16 + fr, s = row & (SEQ - 1);
                f32x4 v[2][2];
#pragma unroll
                for (int bj = 0; bj < 2; ++bj)
#pragma unroll
                    for (int n = 0; n < 2; ++n) v[bj][n] = acc[ai][bj][m][n];
                if (isnorm) {
                    float ss = 0.f;
#pragma unroll
                    for (int bj = 0; bj < 2; ++bj)
#pragma unroll
                        for (int n = 0; n < 2; ++n) { const f32x4 x = v[bj][n]; ss += (x[0] * x[0] + x[1] * x[1]) + (x[2] * x[2] + x[3] * x[3]); }
                    ss += __shfl_xor(ss, 16); ss += __shfl_xor(ss, 32);
                    const float rstd = 1.0f / sqrtf(ss * (1.0f / 64.0f) + EPSN);
#pragma unroll
                    for (int bj = 0; bj < 2; ++bj)
#pragma unroll
                        for (int n = 0; n < 2; ++n) v[bj][n] = v[bj][n] * rstd * gv[bj][n];
                    if (fq == 0) {
                        const f32x4* rp = (const f32x4*)(rope + (size_t)row * 16);
                        const f32x4 c0 = rp[0], c1 = rp[1], s0 = rp[2], s1 = rp[3];
                        const f32x4 x1a = v[0][0], x1b = v[0][1], x2a = v[1][0], x2b = v[1][1];
                        v[0][0] = x1a * c0 - x2a * s0; v[0][1] = x1b * c1 - x2b * s1;
                        v[1][0] = x2a * c0 + x1a * s0; v[1][1] = x2b * c1 + x1b * s1;
                    }
                    if (region == 1) {
#pragma unroll
                        for (int bj = 0; bj < 2; ++bj)
#pragma unroll
                            for (int n = 0; n < 2; ++n) ks[bj][n] += v[bj][n];
                    }
#pragma unroll
                    for (int bj = 0; bj < 2; ++bj)
#pragma unroll
                        for (int n = 0; n < 2; ++n) v[bj][n] = v[bj][n] * qs;
                }
                u32x4 w0, w1;
                w0.x = cvt_pk_bf16(v[0][0][0], v[0][0][1]); w0.y = cvt_pk_bf16(v[0][0][2], v[0][0][3]); w0.z = cvt_pk_bf16(v[0][1][0], v[0][1][1]); w0.w = cvt_pk_bf16(v[0][1][2], v[0][1][3]);
                w1.x = cvt_pk_bf16(v[1][0][0], v[1][0][1]); w1.y = cvt_pk_bf16(v[1][0][2], v[1][0][3]); w1.z = cvt_pk_bf16(v[1][1][0], v[1][1][1]); w1.w = cvt_pk_bf16(v[1][1][2], v[1][1][3]);
                *(u32x4*)(base + (size_t)s * 64) = w0; *(u32x4*)(base + (size_t)s * 64 + 8) = w1;
            }
        if (region == 1) {
            float* kp = kmean + ((size_t)(b * 8 + head) * 8 + (u.pm & 7)) * 64 + 16 * fq;
#pragma unroll
            for (int bj = 0; bj < 2; ++bj)
#pragma unroll
                for (int n = 0; n < 2; ++n)
#pragma unroll
                    for (int e = 0; e < 4; ++e) {
                        float t = ks[bj][n][e];
                        t += __shfl_xor(t, 1); t += __shfl_xor(t, 2); t += __shfl_xor(t, 4); t += __shfl_xor(t, 8);
                        if (fr == 0) atomicAdd(kp + 8 * bj + 4 * n + e, t);
                    }
        }
    }
};
struct EpiRes {
    static constexpr bool PERM = true, AFTER_DRAIN = false;
    const float* xin; float* out; const float* g;
    __device__ __forceinline__ void operator()(const f32x4 (&acc)[2][2][4][2], const Unit& u, int wr, int wc, int fr, int fq) const {
        asm volatile("" : "+v"(fr), "+v"(fq));
        const int b = u.pm >> 3, col0 = u.pn * 256 + wc * 32 + 8 * fq; const float* gp = g + (size_t)b * NMOD + col0;
        f32x4 gv[2][2];
#pragma unroll
        for (int bj = 0; bj < 2; ++bj)
#pragma unroll
            for (int n = 0; n < 2; ++n) gv[bj][n] = *(const f32x4*)(gp + 128 * bj + 4 * n);
#pragma unroll
        for (int ai = 0; ai < 2; ++ai)
#pragma unroll
            for (int m = 0; m < 4; ++m) {
                const size_t off = (size_t)(u.pm * 256 + ai * 128 + wr * 64 + m * 16 + fr) * DM + col0;
#pragma unroll
                for (int bj = 0; bj < 2; ++bj)
#pragma unroll
                    for (int n = 0; n < 2; ++n) { const f32x4 xv = *(const f32x4*)(xin + off + 128 * bj + 4 * n); *(f32x4*)(out + off + 128 * bj + 4 * n) = xv + gv[bj][n] * acc[ai][bj][m][n]; }
            }
    }
};
struct EpiSwiGLU {
    static constexpr bool PERM = true, AFTER_DRAIN = false;
    bf16_t* H;
    __device__ __forceinline__ void operator()(const f32x4 (&acc)[2][2][4][2], const Unit& u, int wr, int wc, int fr, int fq) const {
        asm volatile("" : "+v"(fr), "+v"(fq));
        const int col0 = u.pn * 128 + wc * 32 + 8 * fq;
#pragma unroll
        for (int ai = 0; ai < 2; ++ai)
#pragma unroll
            for (int m = 0; m < 4; ++m) {
                const size_t off = (size_t)(u.pm * 256 + ai * 128 + wr * 64 + m * 16 + fr) * DFF + col0;
                f32x4 h[2];
#pragma unroll
                for (int n = 0; n < 2; ++n) { const f32x4 gg = acc[ai][0][m][n], uu = acc[ai][1][m][n];
#pragma unroll
                    for (int e = 0; e < 4; ++e) h[n][e] = gg[e] * __builtin_amdgcn_rcpf(1.0f + __expf(-gg[e])) * uu[e]; }
                u32x4 w; w.x = cvt_pk_bf16(h[0][0], h[0][1]); w.y = cvt_pk_bf16(h[0][2], h[0][3]); w.z = cvt_pk_bf16(h[1][0], h[1][1]); w.w = cvt_pk_bf16(h[1][2], h[1][3]);
                *(u32x4*)(H + off) = w;
            }
    }
};

__device__ __forceinline__ int map_win(int s) { return (s & ~255) | (((s >> 3) & 1) << 7) | (((s >> 6) & 3) << 5) | (((s >> 4) & 3) << 3) | (s & 7); }
template <int MODE> __device__ __forceinline__ void p0_transpose_item(const float* W, int K, int N, bf16_t* WT, LAS float* scr, int item, int lane) {
    const int nblk = N / 32, kb = item / nblk, nb = item % nblk, k0 = 64 * kb, n0 = 32 * nb;
#pragma unroll 8
    for (int i = 0; i < 32; ++i) { const int kk = 2 * i + (lane >> 5); scr[kk * 33 + (lane & 31)] = W[(size_t)(k0 + kk) * N + n0 + (lane & 31)]; }
    asm volatile("s_waitcnt lgkmcnt(0)" ::: "memory");
    const int c = lane & 7;
#pragma unroll
    for (int j = 0; j < 4; ++j) { const int n = (lane >> 3) + 8 * j; const LAS float* s = scr + (8 * c) * 33 + n;
        u32x4 o; o.x = pk2(s[0 * 33], s[1 * 33]); o.y = pk2(s[2 * 33], s[3 * 33]); o.z = pk2(s[4 * 33], s[5 * 33]); o.w = pk2(s[6 * 33], s[7 * 33]);
        const int ns = n0 + n;
        const int nd = MODE == 0 ? ns : MODE == 1 ? map_win(ns) : (256 * (ns >> 7) + (MODE == 3 ? 128 : 0) + (ns & 127));
        *(u32x4*)(WT + (size_t)nd * K + k0 + 8 * c) = o; }
    asm volatile("s_waitcnt lgkmcnt(0)" ::: "memory");
}
__device__ __forceinline__ float modsum(const float* part, const float* bmod, int l, int b, int n) {
    float s = 0.f;
#pragma unroll
    for (int kc = 0; kc < 16; ++kc) s += part[((size_t)(l * 16 + kc) * 8 + b) * NMOD + n];
    return s + bmod[l * NMOD + n];
}

__device__ __forceinline__ void norm_phase(LAS unsigned char* lds, const float* xin, const float* normw, bf16_t* XN, const float* mod, const float* part, const float* bmod,
                                           int l, int sh_off, int sc_off, bool use_part) {
    int tid = threadIdx.x; asm volatile("" : "+v"(tid));
    const int lane = tid & 63, wave = tid >> 6;
    LAS float* Gs = (LAS float*)lds; LAS float* Ss = Gs + 1024;
    for (int tile = blockIdx.x; tile < MT / 64; tile += gridDim.x) {
        const int b = tile >> 5;
        for (int k = tid; k < DM; k += 512) {
            float sc, sh;
            if (use_part) { sc = modsum(part, bmod, l, b, sc_off + k); sh = modsum(part, bmod, l, b, sh_off + k); }
            else { sc = mod[(size_t)(l * 8 + b) * NMOD + sc_off + k]; sh = mod[(size_t)(l * 8 + b) * NMOD + sh_off + k]; }
            Gs[k] = normw[k] * (1.0f + sc); Ss[k] = sh;
        }
        __syncthreads();
        for (int r = wave; r < 64; r += 8) {
            const size_t row = (size_t)tile * 64 + r;
            const f32x4* xr = (const f32x4*)(xin + row * DM) + lane;
            f32x4 v[4]; float ss = 0.f;
#pragma unroll
            for (int j = 0; j < 4; ++j) { v[j] = xr[64 * j]; ss += (v[j][0] * v[j][0] + v[j][1] * v[j][1]) + (v[j][2] * v[j][2] + v[j][3] * v[j][3]); }
            const float rstd = 1.0f / sqrtf(wave_sum(ss) * (1.0f / DM) + EPSN);
            u32x2* o8 = (u32x2*)(XN + row * DM) + lane;
#pragma unroll
            for (int j = 0; j < 4; ++j) { const int k = 4 * (lane + 64 * j); const f32x4 g = *(const LAS f32x4*)(Gs + k), s = *(const LAS f32x4*)(Ss + k);
                const f32x4 y = v[j] * rstd * g + s; u32x2 w; w.x = cvt_pk_bf16(y[0], y[1]); w.y = cvt_pk_bf16(y[2], y[3]); o8[64 * j] = w; }
        }
        __syncthreads();
    }
}

typedef LAS const char* lds_cptr;
__device__ __forceinline__ int crow(int r, int hi) { return (r & 3) + 8 * (r >> 2) + 4 * hi; }
__device__ __forceinline__ void glds16(const void* gsrc, unsigned lds_dst) { unsigned keep;
    asm volatile("s_mov_b32 %0, m0\n\ts_mov_b32 m0, %2\n\ts_nop 0\n\tglobal_load_lds_dwordx4 %1, off\n\ts_mov_b32 m0, %0" : "=&s"(keep) : "v"(gsrc), "s"(lds_dst) : "memory"); }
typedef short v4i16_t __attribute__((ext_vector_type(4)));
__device__ __forceinline__ s16x4 vtr(lds_cptr p) { return __builtin_bit_cast(s16x4, __builtin_amdgcn_ds_read_tr16_b64_v4i16((LAS v4i16_t*)p)); }
__device__ __forceinline__ float xmax(float v) { auto rr = __builtin_amdgcn_permlane32_swap(__float_as_uint(v), __float_as_uint(v), false, false); return fmaxf(__uint_as_float(rr[0]), __uint_as_float(rr[1])); }
__device__ __forceinline__ float xsum(float v) { auto rr = __builtin_amdgcn_permlane32_swap(__float_as_uint(v), __float_as_uint(v), false, false); return __uint_as_float(rr[0]) + __uint_as_float(rr[1]); }
#define WAIT_BAR0() asm volatile("s_waitcnt vmcnt(0) lgkmcnt(0)\n\ts_barrier" ::: "memory")

template <bool DIFF>
__device__ __forceinline__ void attn_unit(LAS unsigned char* lds, const bf16_t* __restrict__ QKV, bf16_t* __restrict__ Ob, int b, int hx, int qb,
                                          const float* __restrict__ kmean_bh, const float* __restrict__ gain, float lam, float oscale) {
    constexpr int NV = DIFF ? 4 : 2, QROWS = DIFF ? 128 : 256, STAGE = DIFF ? 32768 : 16384, VOFF = DIFF ? 16384 : 8192, BAND = QROWS / 64;
    int tid = threadIdx.x; asm volatile("" : "+v"(tid));
    const int lane = tid & 63, r32 = lane & 31, hi = lane >> 5;
    const int w = __builtin_amdgcn_readfirstlane(tid >> 6);
    const int comp = DIFF ? (w >> 2) : 0, wq = DIFF ? (w & 3) : w;
    const int q0 = qb * QROWS, qpos = q0 + 32 * wq + r32;
    constexpr size_t HS = (size_t)SEQ * 64;
    const bf16_t* Qp; const bf16_t* K0p; const bf16_t* V0p;
    if (DIFF) { Qp = QKV + 3 * QKV_RS + (size_t)(b * 8 + 2 * hx + comp) * HS; K0p = QKV + 4 * QKV_RS + (size_t)(b * 8 + 2 * hx) * HS; V0p = QKV + 5 * QKV_RS + (size_t)(b * 8 + 2 * hx) * HS; }
    else { Qp = QKV + (size_t)(b * 8 + hx) * HS; K0p = QKV + QKV_RS + (size_t)(b * 8 + hx) * HS; V0p = QKV + 2 * QKV_RS + (size_t)(b * 8 + hx) * HS; }
    const unsigned lds0 = (unsigned)(uintptr_t)lds;
    const lds_cptr shm3 = (lds_cptr)lds;
    const bf16_t* ksrc = K0p + (size_t)lane * 64 + w * 8;
    const bf16_t* vsrc = V0p + (size_t)(16 * (w & 3) + (lane >> 2)) * 64 + (w >> 2) * 32 + (lane & 3) * 8;
#define DMA_TILE(t, st) do { const unsigned dst_ = (unsigned)__builtin_amdgcn_readfirstlane(lds0 + (unsigned)(st) * STAGE + (unsigned)w * 1024u); const size_t to_ = (size_t)(t) * 4096; \
        glds16(ksrc + to_, dst_); if (DIFF) glds16(ksrc + HS + to_, dst_ + 8192u); glds16(vsrc + to_, dst_ + VOFF); if (DIFF) glds16(vsrc + HS + to_, dst_ + VOFF + 8192u); } while (0)
    const int NT = (q0 + QROWS) / 64;
    DMA_TILE(0, 0);
    bf16x8 qr[4];
#pragma unroll
    for (int d0 = 0; d0 < 4; ++d0) qr[d0] = *(const bf16x8*)(Qp + (size_t)(q0 + 32 * wq + r32) * 64 + d0 * 16 + hi * 8);
    unsigned sel = 0xFFu;
    if (!DIFF) {
        if (qb <= 3) sel = (1u << qb) - 1u;
        else {
            float g[7];
#pragma unroll
            for (int n = 0; n < 7; ++n) {
                float part = 0.f;
                if (n < qb) {
#pragma unroll
                    for (int d0 = 0; d0 < 4; ++d0) { const f32x4* kp = (const f32x4*)(kmean_bh + n * 64 + 16 * d0 + 8 * hi); const f32x4 ka = kp[0], kb2 = kp[1];
#pragma unroll
                        for (int j = 0; j < 4; ++j) { part += bf2f(qr[d0][j]) * ka[j]; part += bf2f(qr[d0][4 + j]) * kb2[j]; } }
                }
                part = xsum(part);
                g[n] = (n < qb) ? part : -INFINITY;
            }
            sel = 0u;
#pragma unroll
            for (int pick = 0; pick < 3; ++pick) { float best = -INFINITY; int bi = 0;
#pragma unroll
                for (int n = 0; n < 7; ++n) { const bool c = !((sel >> n) & 1u) && (g[n] > best); best = c ? g[n] : best; bi = c ? n : bi; }
                sel |= 1u << bi; }
        }
    }
    f32x16 o[NV];
#pragma unroll
    for (int i = 0; i < NV; ++i) o[i] = f32x16{};
    float mrun = -1e30f, lrun = 0.f;
    WAIT_BAR0();
    for (int t = 0; t < NT; ++t) {
        const int st = t & 1;
        if (t + 1 < NT) DMA_TILE(t + 1, st ^ 1);
        const int jb = t - (NT - BAND);
        bool active = true;
        if (jb >= 0 && 64 * jb > 32 * wq + 31) active = false;
        bool selme = true;
        if (!DIFF && jb < 0) { selme = ((sel >> (t >> 2)) & 1u) != 0u; if (!__any(selme ? 1 : 0)) active = false; }
        if (active) {
            const lds_cptr kb = shm3 + st * STAGE + (DIFF ? comp * 8192 : 0) + hi * 1024 + r32 * 16;
            f32x16 p0 = f32x16{}, p1 = f32x16{};
#pragma unroll
            for (int d0 = 0; d0 < 4; ++d0) {
                const bf16x8 k0 = *(const LAS bf16x8*)(kb + d0 * 2048), k1 = *(const LAS bf16x8*)(kb + d0 * 2048 + 512);
                p0 = __builtin_amdgcn_mfma_f32_32x32x16_bf16(k0, qr[d0], p0, 0, 0, 0);
                p1 = __builtin_amdgcn_mfma_f32_32x32x16_bf16(k1, qr[d0], p1, 0, 0, 0);
            }
            if (jb >= 0) {
                const int kbase = 64 * t + 4 * hi;
#pragma unroll
                for (int r = 0; r < 16; ++r) { const int kv = kbase + (r & 3) + 8 * (r >> 2); if (kv > qpos) p0[r] = -INFINITY; if (kv + 32 > qpos) p1[r] = -INFINITY; }
            }
            if (!DIFF) { if (!selme) {
#pragma unroll
                for (int r = 0; r < 16; ++r) { p0[r] = -INFINITY; p1[r] = -INFINITY; } } }
            float rm = fmaxf(p0[0], p1[0]);
#pragma unroll
            for (int r = 1; r < 16; ++r) rm = fmaxf(rm, fmaxf(p0[r], p1[r]));
            rm = xmax(rm);
            if (__any(rm > mrun + 8.0f ? 1 : 0)) {
                const float mnew = fmaxf(mrun, rm), alpha = __builtin_amdgcn_exp2f(mrun - mnew);
                lrun *= alpha;
#pragma unroll
                for (int i = 0; i < NV; ++i)
#pragma unroll
                    for (int r = 0; r < 16; ++r) o[i][r] *= alpha;
                mrun = mnew;
            }
            float sacc = 0.f;
#pragma unroll
            for (int r = 0; r < 16; ++r) { p0[r] = __builtin_amdgcn_exp2f(p0[r] - mrun); p1[r] = __builtin_amdgcn_exp2f(p1[r] - mrun); sacc += p0[r] + p1[r]; }
            lrun += sacc;
            u32x4 pw[4];
#pragma unroll
            for (int i = 0; i < 4; ++i) { pw[0][i] = cvt_pk_bf16(p0[2 * i], p0[2 * i + 1]); pw[1][i] = cvt_pk_bf16(p0[8 + 2 * i], p0[8 + 2 * i + 1]);
                                          pw[2][i] = cvt_pk_bf16(p1[2 * i], p1[2 * i + 1]); pw[3][i] = cvt_pk_bf16(p1[8 + 2 * i], p1[8 + 2 * i + 1]); }
            const lds_cptr vb = shm3 + st * STAGE + VOFF + (4 * hi + ((lane & 15) >> 2)) * 64 + ((lane >> 4) & 1) * 32 + (lane & 3) * 8;
#pragma unroll
            for (int db = 0; db < NV; ++db)
#pragma unroll
                for (int ks = 0; ks < 4; ++ks) {
                    const int off = (db >> 1) * 8192 + (db & 1) * 4096 + ks * 1024;
                    const s16x4 lo = vtr(vb + off), hh = vtr(vb + off + 512);
                    const bf16x8 a = (bf16x8){lo[0], lo[1], lo[2], lo[3], hh[0], hh[1], hh[2], hh[3]};
                    o[db] = __builtin_amdgcn_mfma_f32_32x32x16_bf16(a, __builtin_bit_cast(bf16x8, pw[ks]), o[db], 0, 0, 0);
                }
        }
        WAIT_BAR0();
    }
#undef DMA_TILE
    const float inv = 1.0f / xsum(lrun);
    const size_t orow = ((size_t)b * SEQ + qpos) * DM;
    if (!DIFF) {
        float ss = 0.f;
#pragma unroll
        for (int db = 0; db < NV; ++db)
#pragma unroll
            for (int r = 0; r < 16; ++r) { o[db][r] *= inv; ss += o[db][r] * o[db][r]; }
        const float rn = 1.0f / sqrtf(xsum(ss) * (1.0f / 64.0f) + EPSN);
#pragma unroll
        for (int db = 0; db < NV; ++db)
#pragma unroll
            for (int g4 = 0; g4 < 4; ++g4) { const int d = 32 * db + 8 * g4 + 4 * hi; const f32x4 gn = *(const f32x4*)(gain + d);
                u32x2 wv; wv.x = cvt_pk_bf16(o[db][4 * g4] * rn * gn[0], o[db][4 * g4 + 1] * rn * gn[1]); wv.y = cvt_pk_bf16(o[db][4 * g4 + 2] * rn * gn[2], o[db][4 * g4 + 3] * rn * gn[3]);
                *(u32x2*)(Ob + orow + hx * 64 + d) = wv; }
    } else {
        LAS float* ex = (LAS float*)lds;
        if (comp == 1) {
#pragma unroll
            for (int db = 0; db < NV; ++db)
#pragma unroll
                for (int r = 0; r < 16; ++r) ex[(wq * 64 + db * 16 + r) * 64 + lane] = o[db][r] * inv;
        }
        WAIT_BAR0();
        if (comp == 0) {
            float ss = 0.f;
#pragma unroll
            for (int db = 0; db < NV; ++db)
#pragma unroll
                for (int r = 0; r < 16; ++r) { const float v = o[db][r] * inv - lam * ex[(wq * 64 + db * 16 + r) * 64 + lane]; o[db][r] = v; ss += v * v; }
            const float rn = oscale / sqrtf(xsum(ss) * (1.0f / 128.0f) + EPSN);
#pragma unroll
            for (int db = 0; db < NV; ++db)
#pragma unroll
                for (int g4 = 0; g4 < 4; ++g4) { const int d = 32 * db + 8 * g4 + 4 * hi; const f32x4 gn = *(const f32x4*)(gain + d);
                    u32x2 wv; wv.x = cvt_pk_bf16(o[db][4 * g4] * rn * gn[0], o[db][4 * g4 + 1] * rn * gn[1]); wv.y = cvt_pk_bf16(o[db][4 * g4 + 2] * rn * gn[2], o[db][4 * g4 + 3] * rn * gn[3]);
                    *(u32x2*)(Ob + orow + 512 + hx * 128 + d) = wv; }
        }
        WAIT_BAR0();
    }
}

struct Args { const void* in[19]; float* out; unsigned char* ws; };
__device__ __forceinline__ const void* ldptr(const Args& a, int i) { asm volatile("" : "+s"(i)); return a.in[i]; }

__global__ void __launch_bounds__(512, 2) fwd_megakernel(Args a) {
    extern __shared__ __attribute__((aligned(16))) unsigned char lds_raw[];
    LAS unsigned char* lds = (LAS unsigned char*)lds_raw;
    cg::grid_group grid = cg::this_grid();
    const int tid = threadIdx.x, lane = tid & 63, wave = __builtin_amdgcn_readfirstlane(tid >> 6), G = gridDim.x;
#define INF(i) ((const float*)ldptr(a, (i)))
    unsigned char* ws = a.ws; float* out = a.out;
    unsigned* ctl = (unsigned*)ws; float* kmean = (float*)(ws + CTL_KMEAN);
    float* mod = (float*)(ws + WS_MOD); float* gains = (float*)(ws + WS_GAINS); float* rope = (float*)(ws + WS_ROPE); float* part = (float*)(ws + WS_PART);
    bf16_t* XN = (bf16_t*)(ws + WS_XN); bf16_t* OB = (bf16_t*)(ws + WS_O); bf16_t* QKV = (bf16_t*)(ws + WS_QKV); bf16_t* HB = (bf16_t*)(ws + WS_H);

    {
        LAS float* scr = (LAS float*)(lds + wave * 16384);
        const int gw = blockIdx.x * 8 + wave, NGW = G * 8;
        constexpr int I_IN = 16 * 96, I_OUT = 16 * 32, I_G = 16 * 88, I_D = 44 * 32, I_L = I_IN + I_OUT + 2 * I_G + I_D;
        for (int it = gw; it < 2 * I_L; it += NGW) {
            const int l = it / I_L; int r = it % I_L; unsigned char* wl = ws + WS_W + (size_t)l * W_LSTRIDE;
            if (r < I_IN) { p0_transpose_item<1>(INF(6) + (size_t)l * DM * NIN, DM, NIN, (bf16_t*)(wl + W_IN), scr, r, lane); continue; } r -= I_IN;
            if (r < I_OUT) { p0_transpose_item<0>(INF(14) + (size_t)l * DM * DM, DM, DM, (bf16_t*)(wl + W_OUT), scr, r, lane); continue; } r -= I_OUT;
            if (r < I_G) { p0_transpose_item<2>(INF(16) + (size_t)l * DM * DFF, DM, DFF, (bf16_t*)(wl + W_GU), scr, r, lane); continue; } r -= I_G;
            if (r < I_G) { p0_transpose_item<3>(INF(17) + (size_t)l * DM * DFF, DM, DFF, (bf16_t*)(wl + W_GU), scr, r, lane); continue; } r -= I_G;
            p0_transpose_item<0>(INF(18) + (size_t)l * DFF * DM, DFF, DM, (bf16_t*)(wl + W_DN), scr, r, lane);
        }
        for (int it = gw; it < 2 * 16 * 96; it += NGW) {
            const int l = it / 1536, r = it % 1536, kc = r / 96, nb = r % 96;
            const float* cvec = INF(1); const float* W = INF(3) + (size_t)l * DM * NMOD + (size_t)(64 * kc) * NMOD + 64 * nb + lane;
            float sv[8], ac[8];
#pragma unroll
            for (int b = 0; b < 8; ++b) { const float cv = cvec[b * DM + 64 * kc + lane]; sv[b] = cv / (1.0f + __expf(-cv)); ac[b] = 0.f; }
#pragma unroll 8
            for (int i = 0; i < 64; ++i) { const float wv = W[(size_t)i * NMOD];
#pragma unroll
                for (int b = 0; b < 8; ++b) ac[b] += __uint_as_float(__builtin_amdgcn_readlane(__float_as_uint(sv[b]), i)) * wv; }
#pragma unroll
            for (int b = 0; b < 8; ++b) part[((size_t)(l * 16 + kc) * 8 + b) * NMOD + 64 * nb + lane] = ac[b];
        }
        if (blockIdx.x == 0 && tid < 128) { const int ll = tid >> 6, d = tid & 63; gains[ll * 256 + d] = INF(7)[tid]; gains[ll * 256 + 64 + d] = INF(8)[tid]; gains[ll * 256 + 128 + d] = INF(10)[tid]; gains[ll * 256 + 192 + d] = INF(11)[tid]; }
        for (int idx = blockIdx.x * 512 + tid; idx < MT * 8; idx += G * 512) {
            const int t = idx >> 3, i = idx & 7;
            const float invf = i == 0 ? 1.0f : i == 1 ? 0.19392274474868576f : i == 2 ? 0.03760603093086393f : i == 3 ? 0.007292664737217109f : i == 4 ? 0.001414213562373095f
                             : i == 5 ? 0.0002742481756762073f : i == 6 ? 5.318295896944988e-05f : 1.031338537721246e-05f;
            const float ang = (float)((const int*)ldptr(a, 2))[t] * invf;
            rope[(size_t)t * 16 + i] = cosf(ang); rope[(size_t)t * 16 + 8 + i] = sinf(ang);
        }
    }
    grid.sync();

#pragma nounroll
    for (int l = 0; l < 2; ++l) {
        unsigned char* wl = ws + WS_W + (size_t)l * W_LSTRIDE;
        const float* xcur = (l == 0) ? INF(0) : out;
        if (l == 0) { for (int idx = blockIdx.x * 512 + tid; idx < 2 * 8 * NMOD; idx += G * 512) { const int ll = idx / (8 * NMOD), r = idx % (8 * NMOD); mod[idx] = modsum(part, INF(4), ll, r / NMOD, r % NMOD); } }
        norm_phase(lds, xcur, INF(5) + l * DM, XN, mod, part, INF(4), l, 0, DM, l == 0);
        grid.sync();
        {
            pg8::Gemm g{XN, (const bf16_t*)(wl + W_IN), MT, NIN, DM}; pg8::StaticOrder S; S.init(MT, NIN, G, (int)blockIdx.x);
            EpiQKV E{QKV, gains + l * 256, rope, kmean + (size_t)l * 32768};
            pg8::gemm_phase<EpiQKV, pg8::StaticOrder, true, true>(lds, g, S, E);
        }
        grid.sync();
        {
            const float* lp = INF(12) + l * 256; float s1 = 0.f, s2 = 0.f;
            for (int i = 0; i < 64; ++i) { s1 += lp[i] * lp[64 + i]; s2 += lp[128 + i] * lp[192 + i]; }
            const float lam_init = (l == 0) ? 0.2f : 0.35550906759096934f;
            const float lam = expf(s1) - expf(s2) + lam_init;
            volatile LAS unsigned* qw = (volatile LAS unsigned*)(lds + LDS_MISC);
            for (;;) {
                if (tid == 0) qw[0] = atomicAdd(ctl + 64 * l, 1u);
                __syncthreads();
                const int idx = (int)qw[0];
                __syncthreads();
                if (idx >= 1024) break;
                constexpr unsigned CTM = 0xab5abfu;
                constexpr unsigned long long CQL = 0x3546758697abcdefull  , CQH = 0x112234ull  ;
                int start = 0, ty = 0, qb = 0, j = 0;
#pragma unroll
                for (int c = 0; c < 24; ++c) { const int tc = (CTM >> c) & 1u, cnt = tc ? 32 : 64; const int qc = (int)(((c < 16) ? (CQL >> (4 * c)) : (CQH >> (4 * (c - 16)))) & 15ull);
                    if (idx >= start && idx < start + cnt) { ty = tc; qb = qc; j = idx - start; } start += cnt; }
                if (ty) attn_unit<true>(lds, QKV, OB, j >> 2, j & 3, qb, nullptr, INF(13) + l * 128, lam, 1.0f - lam_init);
                else attn_unit<false>(lds, QKV, OB, j >> 3, j & 7, qb, kmean + (size_t)l * 32768 + (size_t)j * 512, INF(9) + l * 64, 0.f, 1.f);
            }
        }
        grid.sync();
        {
            pg8::Gemm g{OB, (const bf16_t*)(wl + W_OUT), MT, DM, DM}; pg8::StaticOrder S; S.init(MT, DM, G, (int)blockIdx.x);
            EpiRes E{(l == 0) ? INF(0) : out, out, mod + (size_t)l * 8 * NMOD + 2 * DM};
            pg8::gemm_phase<EpiRes, pg8::StaticOrder, true, true>(lds, g, S, E);
        }
        grid.sync();
        norm_phase(lds, out, INF(15) + l * DM, XN, mod, part, INF(4), l, 3 * DM, 4 * DM, false);
        grid.sync();
        {
            pg8::Gemm g{XN, (const bf16_t*)(wl + W_GU), MT, NGU, DM}; pg8::StaticOrder S; S.init(MT, NGU, G, (int)blockIdx.x);
            EpiSwiGLU E{HB};
            pg8::gemm_phase<EpiSwiGLU, pg8::StaticOrder, true, true>(lds, g, S, E);
        }
        grid.sync();
        {
            pg8::Gemm g{HB, (const bf16_t*)(wl + W_DN), MT, DM, DFF}; pg8::StaticOrder S; S.init(MT, DM, G, (int)blockIdx.x);
            EpiRes E{out, out, mod + (size_t)l * 8 * NMOD + 5 * DM};
            pg8::gemm_phase<EpiRes, pg8::StaticOrder, true, true>(lds, g, S, E);
        }
        if (l == 0) grid.sync();
    }
}

extern "C" void kernel_launch(void* const* d_in, const int* in_sizes, int n_in, void* d_out, int out_size, void* d_ws, size_t ws_size, hipStream_t stream) {
    static int grid = 0;
    if (grid == 0) {
        if (n_in != 19 || out_size != MT * DM || ws_size < WS_END) { fprintf(stderr, "kernel_launch: unexpected problem (n_in %d out %d ws %zu); nothing launched\n", n_in, out_size, ws_size); grid = -1; return; }
        int dev = 0, cus = 0, per_cu = 0;
        if (hipGetDevice(&dev) != hipSuccess || hipDeviceGetAttribute(&cus, hipDeviceAttributeMultiprocessorCount, dev) != hipSuccess) { grid = -1; return; }
        if (hipFuncSetAttribute((const void*)fwd_megakernel, hipFuncAttributeMaxDynamicSharedMemorySize, LDS_BYTES) != hipSuccess) { fprintf(stderr, "kernel_launch: hipFuncSetAttribute failed\n"); grid = -1; return; }
        if (hipOccupancyMaxActiveBlocksPerMultiprocessor(&per_cu, (const void*)fwd_megakernel, 512, LDS_BYTES) != hipSuccess || per_cu < 1) { fprintf(stderr, "kernel_launch: occupancy query gave %d\n", per_cu); per_cu = 1; }
        (void)hipGetLastError();
        grid = cus * per_cu;
        fprintf(stderr, "kernel_launch: grid %d (cus %d x %d)\n", grid, cus, per_cu);
    }
    if (grid < 0) return;
    if (hipMemsetAsync(d_ws, 0, CTL_ZERO_BYTES, stream) != hipSuccess) { fprintf(stderr, "kernel_launch: memset failed\n"); return; }
    Args a{};
    for (int i = 0; i < 19; ++i) a.in[i] = d_in[i];
    a.out = (float*)d_out; a.ws = (unsigned char*)d_ws;
    void* args[] = {&a};
    hipError_t e = hipLaunchCooperativeKernel((const void*)fwd_megakernel, dim3(grid), dim3(512), args, LDS_BYTES, stream);
    if (e != hipSuccess) fprintf(stderr, "kernel_launch: cooperative launch failed: %s (grid %d)\n", hipGetErrorString(e), grid);
}
```

```cpp
#include <hip/hip_runtime.h>
#include <hip/hip_cooperative_groups.h>
#include <cstdio>
#include <cstdint>
namespace cg = cooperative_groups;
namespace pg8 {
#define PG8_LAS __attribute__((address_space(3)))
typedef unsigned short bf16_t;
typedef short bf16x8 __attribute__((ext_vector_type(8)));
typedef float f32x4 __attribute__((ext_vector_type(4)));
typedef unsigned u32x4 __attribute__((ext_vector_type(4)));
constexpr int BM = 256, BK = 64, HALF = 128, HTB = HALF * BK * 2  , STAGE_BYTES = 8 * HTB, NXCD = 8, WGM = 8;

__host__ __device__ __forceinline__ int lds_byte(int r, int c) { const int st = (r >> 4) * 2 + (c >> 5), rr = r & 15, cc = c & 31, ob = rr * 64 + cc * 2; return st * 1024 + (ob ^ (((ob >> 9) & 1) << 5)); }
__host__ __device__ __forceinline__ void stage_rc(int b, int& R, int& C) { const int st = b / 1024, sb = b % 1024, swz = sb ^ (((sb >> 9) & 1) << 5); R = (st >> 1) * 16 + swz / 64; C = (st & 1) * 32 + (swz % 64) / 2; }
__host__ __device__ __forceinline__ int perm32(int rho) { const int n = rho >> 4, i = rho & 15; return 8 * (i >> 2) + 4 * n + (i & 3); }

struct Unit { int pm, pn; };
struct Gemm { const bf16_t* A; const bf16_t* Bt; int M, N, K; };

struct StaticOrder {
    int nM, nN, nwg, G, c;
    __host__ __device__ void init(int M, int N, int G_, int c_) { nM = M / BM; nN = N / BM; nwg = nM * nN; G = G_; c = c_; }
    __host__ __device__ bool next(int i, Unit& u) const {
        const long L = (long)i * G + c; if (L >= nwg) return false;
        int wgid = (int)L; { const int q = nwg / NXCD, r = nwg % NXCD, xcd = wgid % NXCD, off = wgid / NXCD; wgid = (xcd < r ? xcd * (q + 1) : r * (q + 1) + (xcd - r) * q) + off; }
        const int nig = WGM * nN, gid = wgid / nig, fm = gid * WGM, gsz = (nM - fm) < WGM ? (nM - fm) : WGM;
        u.pm = fm + ((wgid % nig) % gsz); u.pn = (wgid % nig) / gsz; return true;
    }
    __device__ __forceinline__ void a_ready(const Unit&) const {}
    __device__ __forceinline__ void done(const Unit&) const {}
};
__device__ __forceinline__ unsigned cvt_pk_bf16(float lo, float hi) { unsigned r; asm volatile("v_cvt_pk_bf16_f32 %0, %1, %2" : "=v"(r) : "v"(lo), "v"(hi)); return r; }
typedef float f32x2 __attribute__((ext_vector_type(2)));
template <class Epi, class Sched, bool ALIGN_EPI = false, bool SP2 = false>
__device__ __forceinline__ void gemm_phase(PG8_LAS unsigned char* lds, const Gemm g, const Sched& S, const Epi& E) {
    int tid = threadIdx.x; asm volatile("" : "+v"(tid));
    const int wid = __builtin_amdgcn_readfirstlane(tid >> 6), lane = tid & 63, wr = wid >> 2, wc = wid & 3, fr = lane & 15, fq = lane >> 4;
    const int K = g.K, nt = K / BK;
    unsigned voffA[2], voffB[2];
#pragma unroll
    for (int i = 0; i < 2; ++i) { int R, C; stage_rc(tid * 16 + i * 8192, R, C); const int Rb = Epi::PERM ? ((R & ~31) + perm32(R & 31)) : R;
        voffA[i] = (unsigned)(R * K + C) * 2u; voffB[i] = (unsigned)(Rb * K + C) * 2u; }
    const size_t kstep = (size_t)(BK * 2);
    const size_t hstep = (size_t)HALF * K * 2;
    const size_t tstep = 2 * hstep;
    const unsigned ldsw = (unsigned)wid * 1024u;
    const int aoff = lds_byte(wr * 64 + fr, fq * 8), boff = lds_byte(wc * 32 + fr, fq * 8);
#define PG8_SA(b, h) (((b) * 2 + (h)) * HTB)
#define PG8_SB(b, h) ((4 + (b) * 2 + (h)) * HTB)
#define PG8_STAGE(bufoff, gbase, voff) do { _Pragma("unroll") for (int _i = 0; _i < 2; ++_i) \
        __builtin_amdgcn_global_load_lds((const unsigned*)((const char*)(gbase) + (voff)[_i]), (PG8_LAS unsigned*)(lds + (bufoff) + ldsw + _i * 8192), 16, 0, 0); } while (0)
#define PG8_LDA(dst, b, h) do { _Pragma("unroll") for (int m = 0; m < 4; ++m) _Pragma("unroll") for (int k = 0; k < 2; ++k) dst[m][k] = *(const PG8_LAS bf16x8*)(lds + PG8_SA(b, h) + aoff + m * 2048 + k * 1024); } while (0)
#define PG8_LDB(dst, b, h) do { _Pragma("unroll") for (int n = 0; n < 2; ++n) _Pragma("unroll") for (int k = 0; k < 2; ++k) dst[n][k] = *(const PG8_LAS bf16x8*)(lds + PG8_SB(b, h) + boff + n * 2048 + k * 1024); } while (0)
#define PG8_MMA(ai, bj, At, Bt) do { __builtin_amdgcn_s_setprio(1); _Pragma("unroll") for (int m = 0; m < 4; ++m) _Pragma("unroll") for (int n = 0; n < 2; ++n) _Pragma("unroll") for (int k = 0; k < 2; ++k) \
        acc[ai][bj][m][n] = __builtin_amdgcn_mfma_f32_16x16x32_bf16(Bt[n][k], At[m][k], acc[ai][bj][m][n], 0, 0, 0); __builtin_amdgcn_s_setprio(0); } while (0)
#define PG8_WAIT_V(n) asm volatile("s_waitcnt vmcnt(" #n ")" ::: "memory")
#define PG8_WAIT_L(n) asm volatile("s_waitcnt lgkmcnt(" #n ")" ::: "memory")
#define PG8_BAR __builtin_amdgcn_s_barrier()
#define PG8_SCHED __builtin_amdgcn_sched_barrier(0)
    Unit cur, nxt; int ui = 0;
    if (!S.next(0, cur)) return;
    f32x4 acc[2][2][4][2];
#pragma unroll
    for (int a = 0; a < 2; ++a)
#pragma unroll
        for (int b = 0; b < 2; ++b)
#pragma unroll
            for (int m = 0; m < 4; ++m)
#pragma unroll
                for (int n = 0; n < 2; ++n) acc[a][b][m][n] = (f32x4){0.f, 0.f, 0.f, 0.f};
    bf16x8 At[4][2], B0[2][2], B1[2][2];
    const char* cA = (const char*)g.A + (size_t)cur.pm * tstep; const char* cB = (const char*)g.Bt + (size_t)cur.pn * tstep;
    S.a_ready(cur);
    if constexpr (SP2) {
        PG8_STAGE(PG8_SB(0, 0), cB, voffB); PG8_STAGE(PG8_SB(0, 1), cB + hstep, voffB); PG8_STAGE(PG8_SA(0, 0), cA, voffA); PG8_STAGE(PG8_SA(0, 1), cA + hstep, voffA);
        if (wr == 1) PG8_BAR;
        PG8_WAIT_V(2); PG8_BAR;
        PG8_STAGE(PG8_SB(1, 0), cB + kstep, voffB); PG8_STAGE(PG8_SA(1, 0), cA + kstep, voffA); PG8_STAGE(PG8_SB(1, 1), cB + hstep + kstep, voffB);
        PG8_WAIT_V(6); PG8_BAR;
    } else {
        PG8_STAGE(PG8_SB(0, 0), cB, voffB); PG8_STAGE(PG8_SA(0, 0), cA, voffA); PG8_STAGE(PG8_SB(0, 1), cB + hstep, voffB); PG8_STAGE(PG8_SA(0, 1), cA + hstep, voffA);
        if (wr == 1) PG8_BAR;
        PG8_WAIT_V(4); PG8_BAR;
        PG8_STAGE(PG8_SB(1, 0), cB + kstep, voffB); PG8_STAGE(PG8_SA(1, 0), cA + kstep, voffA); PG8_STAGE(PG8_SB(1, 1), cB + hstep + kstep, voffB);
        PG8_WAIT_V(6); PG8_BAR;
    }
    for (;;) {
        const bool has_next = S.next(ui + 1, nxt);
        const char* nA = has_next ? (const char*)g.A + (size_t)nxt.pm * tstep : cA; const char* nB = has_next ? (const char*)g.Bt + (size_t)nxt.pn * tstep : cB;
        for (int t = 0; t < nt; t += 2) {
            const bool last = (t == nt - 2);
            const char* a1 = cA + (size_t)(t + 1) * kstep;
            const char* a2 = last ? nA : cA + (size_t)(t + 2) * kstep; const char* b2 = last ? nB : cB + (size_t)(t + 2) * kstep;
            const char* a3 = a2 + kstep; const char* b3 = b2 + kstep;
            if (last && has_next) S.a_ready(nxt);
            if constexpr (SP2) {
            PG8_LDB(B0, 0, 0); PG8_LDB(B1, 0, 1); PG8_SCHED; PG8_LDA(At, 0, 0); PG8_STAGE(PG8_SA(1, 1), a1 + hstep, voffA);
            PG8_WAIT_V(8); PG8_WAIT_L(0); PG8_BAR; PG8_MMA(0, 0, At, B0); PG8_MMA(0, 1, At, B1); PG8_BAR; PG8_SCHED;
            PG8_LDA(At, 0, 1); PG8_STAGE(PG8_SB(0, 0), b2, voffB); PG8_STAGE(PG8_SB(0, 1), b2 + hstep, voffB); PG8_STAGE(PG8_SA(0, 0), a2, voffA);
            PG8_WAIT_V(8); PG8_WAIT_L(0); PG8_BAR; PG8_MMA(1, 0, At, B0); PG8_MMA(1, 1, At, B1); PG8_BAR; PG8_SCHED;
            PG8_LDB(B0, 1, 0); PG8_LDB(B1, 1, 1); PG8_SCHED; PG8_LDA(At, 1, 0); PG8_STAGE(PG8_SA(0, 1), a2 + hstep, voffA);
            PG8_WAIT_V(8); PG8_WAIT_L(0); PG8_BAR; PG8_MMA(0, 0, At, B0); PG8_MMA(0, 1, At, B1); PG8_BAR; PG8_SCHED;
            PG8_LDA(At, 1, 1); PG8_STAGE(PG8_SB(1, 0), b3, voffB); PG8_STAGE(PG8_SB(1, 1), b3 + hstep, voffB); PG8_STAGE(PG8_SA(1, 0), a3, voffA);
            PG8_WAIT_V(8); PG8_WAIT_L(0); PG8_BAR; PG8_MMA(1, 0, At, B0); PG8_MMA(1, 1, At, B1); PG8_BAR; PG8_SCHED;
            } else {
            PG8_LDB(B0, 0, 0); PG8_SCHED; PG8_LDA(At, 0, 0); PG8_STAGE(PG8_SA(1, 1), a1 + hstep, voffA);
            PG8_WAIT_L(8); PG8_BAR; PG8_WAIT_L(0); PG8_MMA(0, 0, At, B0); PG8_BAR; PG8_SCHED;
            PG8_LDB(B1, 0, 1); PG8_STAGE(PG8_SB(0, 0), b2, voffB);
            PG8_BAR; PG8_WAIT_L(0); PG8_MMA(0, 1, At, B1); PG8_BAR;
            PG8_LDA(At, 0, 1); PG8_STAGE(PG8_SA(0, 0), a2, voffA);
            PG8_BAR; PG8_WAIT_L(0); PG8_MMA(1, 0, At, B0); PG8_BAR; PG8_SCHED;
            PG8_STAGE(PG8_SB(0, 1), b2 + hstep, voffB);
            PG8_WAIT_V(6); PG8_BAR; PG8_MMA(1, 1, At, B1); PG8_BAR;
            PG8_LDB(B0, 1, 0); PG8_SCHED; PG8_LDA(At, 1, 0); PG8_STAGE(PG8_SA(0, 1), a2 + hstep, voffA);
            PG8_WAIT_L(8); PG8_BAR; PG8_WAIT_L(0); PG8_MMA(0, 0, At, B0); PG8_BAR; PG8_SCHED;
            PG8_LDB(B1, 1, 1); PG8_STAGE(PG8_SB(1, 0), b3, voffB);
            PG8_BAR; PG8_WAIT_L(0); PG8_MMA(0, 1, At, B1); PG8_BAR;
            PG8_LDA(At, 1, 1); PG8_STAGE(PG8_SA(1, 0), a3, voffA);
            PG8_BAR; PG8_WAIT_L(0); PG8_MMA(1, 0, At, B0); PG8_BAR; PG8_SCHED;
            PG8_STAGE(PG8_SB(1, 1), b3 + hstep, voffB);
            PG8_WAIT_V(6); PG8_BAR; PG8_MMA(1, 1, At, B1); PG8_BAR;
            }
        }
        if constexpr (ALIGN_EPI) { if (wr == 0) PG8_BAR; }
        if constexpr (!Epi::AFTER_DRAIN) { E(acc, cur, wr, wc, fr, fq); S.done(cur); }
        if (!has_next) break;
#pragma unroll
        for (int a = 0; a < 2; ++a)
#pragma unroll
            for (int b = 0; b < 2; ++b)
#pragma unroll
                for (int m = 0; m < 4; ++m)
#pragma unroll
                    for (int n = 0; n < 2; ++n) acc[a][b][m][n] = (f32x4){0.f, 0.f, 0.f, 0.f};
        cur = nxt; cA = nA; cB = nB; ++ui;
        if constexpr (ALIGN_EPI) { if (wr == 1) PG8_BAR; }
    }
    PG8_WAIT_V(0);
    if constexpr (!ALIGN_EPI) { if (wr == 0) PG8_BAR; }
    PG8_BAR;
    if constexpr (Epi::AFTER_DRAIN) { E.fused(acc, cur, wr, wc, fr, fq, lds, wid, lane); S.done(cur); }
#undef PG8_SA
#undef PG8_SB
#undef PG8_STAGE
#undef PG8_LDA
#undef PG8_LDB
#undef PG8_MMA
#undef PG8_WAIT_V
#undef PG8_WAIT_L
#undef PG8_BAR
#undef PG8_SCHED
}
}

#define LAS __attribute__((address_space(3)))
using pg8::f32x4; using pg8::u32x4; using pg8::bf16_t; using pg8::bf16x8; using pg8::Unit; using pg8::cvt_pk_bf16;
typedef float f32x16 __attribute__((ext_vector_type(16)));
typedef short s16x4 __attribute__((ext_vector_type(4)));
typedef unsigned u32x2 __attribute__((ext_vector_type(2)));
constexpr int NB = 8, SEQ = 2048, DM = 1024, MT = NB * SEQ, NIN = 3072, DFF = 2816, NGU = 2 * DFF, NMOD = 6 * DM;
constexpr float EPSN = 1e-6f;
constexpr float C2 = 0.125f * 1.4426950408889634f;
constexpr size_t MiB = 1u << 20;
constexpr size_t CTL_ZERO_BYTES = 1 * MiB, CTL_KMEAN = 65536;
constexpr size_t WS_GAINS = 1 * MiB + 393216, WS_MOD = 1 * MiB, WS_ROPE = 1 * MiB + 512 * 1024, WS_PART = 3 * MiB, WS_W = 10 * MiB;
constexpr size_t W_LSTRIDE = 24 * MiB + 512 * 1024, W_IN = 0, W_OUT = 6 * MiB, W_GU = 8 * MiB, W_DN = 19 * MiB;
constexpr size_t WS_XN = 60 * MiB, WS_O = 92 * MiB, WS_QKV = 124 * MiB, WS_H = 124 * MiB, WS_END = 220 * MiB;
constexpr size_t QKV_RS = (size_t)NB * 8 * SEQ * 64;
constexpr int LDS_BYTES = 147456, LDS_MISC = 131072;
constexpr int CW_BAR = 4096;

__device__ __forceinline__ unsigned f2bf(float f) { unsigned u = __builtin_bit_cast(unsigned, f); return (u + 0x7fffu + ((u >> 16) & 1u)) >> 16; }
__device__ __forceinline__ unsigned pk2(float lo, float hi) { return f2bf(lo) | (f2bf(hi) << 16); }
__device__ __forceinline__ float bf2f(short s) { return __uint_as_float(((unsigned)(unsigned short)s) << 16); }
__device__ __forceinline__ float wave_sum(float v) {
#pragma unroll
    for (int o = 1; o < 64; o <<= 1) v += __shfl_xor(v, o);
    return v;
}

struct EpiQKV {
    static constexpr bool PERM = true, AFTER_DRAIN = false;
    bf16_t* qkv; const float* gains; const float* rope; float* kmean;
    __device__ __forceinline__ void operator()(const f32x4 (&acc)[2][2][4][2], const Unit& u, int wr, int wc, int fr, int fq) const {
        asm volatile("" : "+v"(fr), "+v"(fq));
        const int region = u.pn >> 1, head = (u.pn & 1) * 4 + wc, b = u.pm >> 3;
        const bool isnorm = (region != 2) && (region != 5);
        const float* gp = gains + 64 * (isnorm ? (region - (region > 2 ? 1 : 0)) : 0);
        f32x4 gv[2][2];
#pragma unroll
        for (int bj = 0; bj < 2; ++bj)
#pragma unroll
            for (int n = 0; n < 2; ++n) gv[bj][n] = *(const f32x4*)(gp + 16 * fq + 8 * bj + 4 * n);
        const float qs = (region == 0 || region == 3) ? C2 : 1.f;
        f32x4 ks[2][2];
#pragma unroll
        for (int bj = 0; bj < 2; ++bj)
#pragma unroll
            for (int n = 0; n < 2; ++n) ks[bj][n] = (f32x4){0.f, 0.f, 0.f, 0.f};
        bf16_t* base = qkv + (size_t)region * QKV_RS + ((size_t)(b * 8 + head) * SEQ) * 64 + 16 * fq;
#pragma unroll
        for (int ai = 0; ai < 2; ++ai)
#pragma unroll
            for (int m = 0; m < 4; ++m) {
                const int row = u.pm * 256 + ai * 128 + wr * 64 + m * 16 + fr, s = row & (SEQ - 1);
                f32x4 v[2][2];
#pragma unroll
                for (int bj = 0; bj < 2; ++bj)
#pragma unroll
                    for (int n = 0; n < 2; ++n) v[bj][n] = acc[ai][bj][m][n];
                if (isnorm) {
                    float ss = 0.f;
#pragma unroll
                    for (int bj = 0; bj < 2; ++bj)
#pragma unroll
                        for (int n = 0; n < 2; ++n) { const f32x4 x = v[bj][n]; ss += (x[0] * x[0] + x[1] * x[1]) + (x[2] * x[2] + x[3] * x[3]); }
                    ss += __shfl_xor(ss, 16); ss += __shfl_xor(ss, 32);
                    const float rstd = __builtin_amdgcn_rsqf(ss * (1.0f / 64.0f) + EPSN);
#pragma unroll
                    for (int bj = 0; bj < 2; ++bj)
#pragma unroll
                        for (int n = 0; n < 2; ++n) v[bj][n] = v[bj][n] * rstd * gv[bj][n];
                    if (fq == 0) {
                        const f32x4* rp = (const f32x4*)(rope + (size_t)row * 16);
                        const f32x4 c0 = rp[0], c1 = rp[1], s0 = rp[2], s1 = rp[3];
                        const f32x4 x1a = v[0][0], x1b = v[0][1], x2a = v[1][0], x2b = v[1][1];
                        v[0][0] = x1a * c0 - x2a * s0; v[0][1] = x1b * c1 - x2b * s1;
                        v[1][0] = x2a * c0 + x1a * s0; v[1][1] = x2b * c1 + x1b * s1;
                    }
                    if (region == 1) {
#pragma unroll
                        for (int bj = 0; bj < 2; ++bj)
#pragma unroll
                            for (int n = 0; n < 2; ++n) ks[bj][n] += v[bj][n];
                    }
#pragma unroll
                    for (int bj = 0; bj < 2; ++bj)
#pragma unroll
                        for (int n = 0; n < 2; ++n) v[bj][n] = v[bj][n] * qs;
                }
                u32x4 w0, w1;
                w0.x = cvt_pk_bf16(v[0][0][0], v[0][0][1]); w0.y = cvt_pk_bf16(v[0][0][2], v[0][0][3]); w0.z = cvt_pk_bf16(v[0][1][0], v[0][1][1]); w0.w = cvt_pk_bf16(v[0][1][2], v[0][1][3]);
                w1.x = cvt_pk_bf16(v[1][0][0], v[1][0][1]); w1.y = cvt_pk_bf16(v[1][0][2], v[1][0][3]); w1.z = cvt_pk_bf16(v[1][1][0], v[1][1][1]); w1.w = cvt_pk_bf16(v[1][1][2], v[1][1][3]);
                *(u32x4*)(base + (size_t)s * 64) = w0; *(u32x4*)(base + (size_t)s * 64 + 8) = w1;
            }
        if (region == 1) {
            float* kp = kmean + ((size_t)(b * 8 + head) * 8 + (u.pm & 7)) * 64 + 16 * fq;
#pragma unroll
            for (int bj = 0; bj < 2; ++bj)
#pragma unroll
                for (int n = 0; n < 2; ++n)
#pragma unroll
                    for (int e = 0; e < 4; ++e) {
                        float t = ks[bj][n][e];
                        t += __shfl_xor(t, 1); t += __shfl_xor(t, 2); t += __shfl_xor(t, 4); t += __shfl_xor(t, 8);
                        if (fr == 0) atomicAdd(kp + 8 * bj + 4 * n + e, t);
                    }
        }
    }
};
struct EpiRes {
    static constexpr bool PERM = false, AFTER_DRAIN = false;
    const float* xin; float* out; const float* g;
    __device__ __forceinline__ void operator()(const f32x4 (&acc)[2][2][4][2], const Unit& u, int wr, int wc, int fr, int fq) const {
        asm volatile("" : "+v"(fr), "+v"(fq));
        const int b = u.pm >> 3, col0 = u.pn * 256 + wc * 32 + 4 * fq; const float* gp = g + (size_t)b * NMOD + col0;
        f32x4 gv[2][2];
#pragma unroll
        for (int bj = 0; bj < 2; ++bj)
#pragma unroll
            for (int n = 0; n < 2; ++n) gv[bj][n] = *(const f32x4*)(gp + 128 * bj + 16 * n);
#pragma unroll
        for (int ai = 0; ai < 2; ++ai)
#pragma unroll
            for (int m = 0; m < 4; ++m) {
                const size_t off = (size_t)(u.pm * 256 + ai * 128 + wr * 64 + m * 16 + fr) * DM + col0;
                f32x4 xv[2][2];
#pragma unroll
                for (int bj = 0; bj < 2; ++bj)
#pragma unroll
                    for (int n = 0; n < 2; ++n) xv[bj][n] = *(const f32x4*)(xin + off + 128 * bj + 16 * n);
#pragma unroll
                for (int bj = 0; bj < 2; ++bj)
#pragma unroll
                    for (int n = 0; n < 2; ++n) *(f32x4*)(out + off + 128 * bj + 16 * n) = xv[bj][n] + gv[bj][n] * acc[ai][bj][m][n];
            }
    }
};
struct EpiSwiGLU {
    static constexpr bool PERM = true, AFTER_DRAIN = false;
    bf16_t* H;
    __device__ __forceinline__ void operator()(const f32x4 (&acc)[2][2][4][2], const Unit& u, int wr, int wc, int fr, int fq) const {
        asm volatile("" : "+v"(fr), "+v"(fq));
        const int col0 = u.pn * 128 + wc * 32 + 8 * fq;
#pragma unroll
        for (int ai = 0; ai < 2; ++ai)
#pragma unroll
            for (int m = 0; m < 4; ++m) {
                const size_t off = (size_t)(u.pm * 256 + ai * 128 + wr * 64 + m * 16 + fr) * DFF + col0;
                f32x4 h[2];
#pragma unroll
                for (int n = 0; n < 2; ++n) { const f32x4 gg = acc[ai][0][m][n], uu = acc[ai][1][m][n];
#pragma unroll
                    for (int e = 0; e < 4; ++e) h[n][e] = gg[e] * __builtin_amdgcn_rcpf(1.0f + __expf(-gg[e])) * uu[e]; }
                u32x4 w; w.x = cvt_pk_bf16(h[0][0], h[0][1]); w.y = cvt_pk_bf16(h[0][2], h[0][3]); w.z = cvt_pk_bf16(h[1][0], h[1][1]); w.w = cvt_pk_bf16(h[1][2], h[1][3]);
                *(u32x4*)(H + off) = w;
            }
    }
};

__device__ __forceinline__ int map_win(int s) { return (s & ~255) | (((s >> 3) & 1) << 7) | (((s >> 6) & 3) << 5) | (((s >> 4) & 3) << 3) | (s & 7); }
template <int MODE> __device__ __forceinline__ void p0_transpose_item(const float* W, int K, int N, bf16_t* WT, LAS float* scr, int item, int lane) {
    const int nblk = N / 32, kb = item / nblk, nb = item % nblk, k0 = 64 * kb, n0 = 32 * nb;
#pragma unroll 8
    for (int i = 0; i < 32; ++i) { const int kk = 2 * i + (lane >> 5); scr[kk * 33 + (lane & 31)] = W[(size_t)(k0 + kk) * N + n0 + (lane & 31)]; }
    asm volatile("s_waitcnt lgkmcnt(0)" ::: "memory");
    const int c = lane & 7;
#pragma unroll
    for (int j = 0; j < 4; ++j) { const int n = (lane >> 3) + 8 * j; const LAS float* s = scr + (8 * c) * 33 + n;
        u32x4 o; o.x = pk2(s[0 * 33], s[1 * 33]); o.y = pk2(s[2 * 33], s[3 * 33]); o.z = pk2(s[4 * 33], s[5 * 33]); o.w = pk2(s[6 * 33], s[7 * 33]);
        const int ns = n0 + n;
        const int nd = MODE == 0 ? ns : MODE == 1 ? map_win(ns) : (256 * (ns >> 7) + (MODE == 3 ? 128 : 0) + (ns & 127));
        *(u32x4*)(WT + (size_t)nd * K + k0 + 8 * c) = o; }
    asm volatile("s_waitcnt lgkmcnt(0)" ::: "memory");
}
__device__ __forceinline__ float modsum(const float* part, const float* bmod, int l, int b, int n) {
    float s = 0.f;
#pragma unroll
    for (int kc = 0; kc < 16; ++kc) s += part[((size_t)(l * 16 + kc) * 8 + b) * NMOD + n];
    return s + bmod[l * NMOD + n];
}

__device__ __forceinline__ void norm_phase(LAS unsigned char* lds, const float* xin, const float* normw, bf16_t* XN, const float* mod, const float* part, const float* bmod,
                                           int l, int sh_off, int sc_off, bool use_part) {
    int tid = threadIdx.x; asm volatile("" : "+v"(tid));
    const int lane = tid & 63, wave = tid >> 6;
    LAS float* Gs = (LAS float*)lds; LAS float* Ss = Gs + 1024;
    for (int tile = blockIdx.x; tile < MT / 64; tile += gridDim.x) {
        const int b = tile >> 5;
        for (int k = tid; k < DM; k += 512) {
            float sc, sh;
            if (use_part) { sc = modsum(part, bmod, l, b, sc_off + k); sh = modsum(part, bmod, l, b, sh_off + k); }
            else { sc = mod[(size_t)(l * 8 + b) * NMOD + sc_off + k]; sh = mod[(size_t)(l * 8 + b) * NMOD + sh_off + k]; }
            Gs[k] = normw[k] * (1.0f + sc); Ss[k] = sh;
        }
        __syncthreads();
        for (int r = wave * 8; r < wave * 8 + 8; r += 4) {
            const size_t row = (size_t)tile * 64 + r;
            f32x4 v[4][4]; float ss[4];
#pragma unroll
            for (int q = 0; q < 4; ++q) { const f32x4* xr = (const f32x4*)(xin + (row + q) * DM) + lane;
#pragma unroll
                for (int j = 0; j < 4; ++j) v[q][j] = xr[64 * j]; }
#pragma unroll
            for (int q = 0; q < 4; ++q) { float a = 0.f;
#pragma unroll
                for (int j = 0; j < 4; ++j) a += (v[q][j][0] * v[q][j][0] + v[q][j][1] * v[q][j][1]) + (v[q][j][2] * v[q][j][2] + v[q][j][3] * v[q][j][3]);
                ss[q] = a; }
#pragma unroll
            for (int o = 1; o < 64; o <<= 1) {
#pragma unroll
                for (int q = 0; q < 4; ++q) ss[q] += __shfl_xor(ss[q], o); }
#pragma unroll
            for (int q = 0; q < 4; ++q) {
                const float rstd = __builtin_amdgcn_rsqf(ss[q] * (1.0f / DM) + EPSN);
                u32x2* o8 = (u32x2*)(XN + (row + q) * DM) + lane;
#pragma unroll
                for (int j = 0; j < 4; ++j) { const int k = 4 * (lane + 64 * j); const f32x4 g = *(const LAS f32x4*)(Gs + k), sh = *(const LAS f32x4*)(Ss + k);
                    const f32x4 y = v[q][j] * rstd * g + sh; u32x2 w; w.x = cvt_pk_bf16(y[0], y[1]); w.y = cvt_pk_bf16(y[2], y[3]); o8[64 * j] = w; }
            }
        }
        __syncthreads();
    }
}

typedef LAS const char* lds_cptr;
__device__ __forceinline__ int crow(int r, int hi) { return (r & 3) + 8 * (r >> 2) + 4 * hi; }
__device__ __forceinline__ void glds16(const void* gsrc, unsigned lds_dst) { unsigned keep;
    asm volatile("s_mov_b32 %0, m0\n\ts_mov_b32 m0, %2\n\ts_nop 0\n\tglobal_load_lds_dwordx4 %1, off\n\ts_mov_b32 m0, %0" : "=&s"(keep) : "v"(gsrc), "s"(lds_dst) : "memory"); }
typedef short v4i16_t __attribute__((ext_vector_type(4)));
__device__ __forceinline__ s16x4 vtr(lds_cptr p) { return __builtin_bit_cast(s16x4, __builtin_amdgcn_ds_read_tr16_b64_v4i16((LAS v4i16_t*)p)); }
__device__ __forceinline__ float xmax(float v) { auto rr = __builtin_amdgcn_permlane32_swap(__float_as_uint(v), __float_as_uint(v), false, false); return fmaxf(__uint_as_float(rr[0]), __uint_as_float(rr[1])); }
__device__ __forceinline__ float xsum(float v) { auto rr = __builtin_amdgcn_permlane32_swap(__float_as_uint(v), __float_as_uint(v), false, false); return __uint_as_float(rr[0]) + __uint_as_float(rr[1]); }
#define WAIT_BAR0() asm volatile("s_waitcnt vmcnt(0) lgkmcnt(0)\n\ts_barrier" ::: "memory")

template <bool DIFF>
__device__ __forceinline__ void attn_unit(LAS unsigned char* lds, const bf16_t* __restrict__ QKV, bf16_t* __restrict__ Ob, int b, int hx, int qb,
                                          const float* __restrict__ kmean_bh, const float* __restrict__ gain, float lam, float oscale) {
    constexpr int NV = DIFF ? 4 : 2, QROWS = DIFF ? 128 : 256, STAGE = DIFF ? 32768 : 16384, VOFF = DIFF ? 16384 : 8192, BAND = QROWS / 64;
    int tid = threadIdx.x; asm volatile("" : "+v"(tid));
    const int lane = tid & 63, r32 = lane & 31, hi = lane >> 5;
    const int w = __builtin_amdgcn_readfirstlane(tid >> 6);
    const int comp = DIFF ? (w >> 2) : 0, wq = DIFF ? (w & 3) : w;
    const int q0 = qb * QROWS, qpos = q0 + 32 * wq + r32;
    constexpr size_t HS = (size_t)SEQ * 64;
    const bf16_t* Qp; const bf16_t* K0p; const bf16_t* V0p;
    if (DIFF) { Qp = QKV + 3 * QKV_RS + (size_t)(b * 8 + 2 * hx + comp) * HS; K0p = QKV + 4 * QKV_RS + (size_t)(b * 8 + 2 * hx) * HS; V0p = QKV + 5 * QKV_RS + (size_t)(b * 8 + 2 * hx) * HS; }
    else { Qp = QKV + (size_t)(b * 8 + hx) * HS; K0p = QKV + QKV_RS + (size_t)(b * 8 + hx) * HS; V0p = QKV + 2 * QKV_RS + (size_t)(b * 8 + hx) * HS; }
    const unsigned lds0 = (unsigned)(uintptr_t)lds;
    const lds_cptr shm3 = (lds_cptr)lds;
    const bf16_t* ksrc = K0p + (size_t)lane * 64 + w * 8;
    const bf16_t* vsrc = V0p + (size_t)(16 * (w & 3) + (lane >> 2)) * 64 + (w >> 2) * 32 + (lane & 3) * 8;
#define DMA_TILE(t, st) do { const unsigned dst_ = (unsigned)__builtin_amdgcn_readfirstlane(lds0 + (unsigned)(st) * STAGE + (unsigned)w * 1024u); const size_t to_ = (size_t)(t) * 4096; \
        glds16(ksrc + to_, dst_); if (DIFF) glds16(ksrc + HS + to_, dst_ + 8192u); glds16(vsrc + to_, dst_ + VOFF); if (DIFF) glds16(vsrc + HS + to_, dst_ + VOFF + 8192u); } while (0)
    const int NT = (q0 + QROWS) / 64;
    DMA_TILE(0, 0);
    bf16x8 qr[4];
#pragma unroll
    for (int d0 = 0; d0 < 4; ++d0) qr[d0] = *(const bf16x8*)(Qp + (size_t)(q0 + 32 * wq + r32) * 64 + d0 * 16 + hi * 8);
    unsigned sel = 0xFFu;
    if (!DIFF) {
        if (qb <= 3) sel = (1u << qb) - 1u;
        else {
            float g[7];
#pragma unroll
            for (int n = 0; n < 7; ++n) {
                float part = 0.f;
                if (n < qb) {
#pragma unroll
                    for (int d0 = 0; d0 < 4; ++d0) { const f32x4* kp = (const f32x4*)(kmean_bh + n * 64 + 16 * d0 + 8 * hi); const f32x4 ka = kp[0], kb2 = kp[1];
#pragma unroll
                        for (int j = 0; j < 4; ++j) { part += bf2f(qr[d0][j]) * ka[j]; part += bf2f(qr[d0][4 + j]) * kb2[j]; } }
                }
                part = xsum(part);
                g[n] = (n < qb) ? part : -INFINITY;
            }
            sel = 0u;
#pragma unroll
            for (int pick = 0; pick < 3; ++pick) { float best = -INFINITY; int bi = 0;
#pragma unroll
                for (int n = 0; n < 7; ++n) { const bool c = !((sel >> n) & 1u) && (g[n] > best); best = c ? g[n] : best; bi = c ? n : bi; }
                sel |= 1u << bi; }
        }
    }
    f32x16 o[NV];
#pragma unroll
    for (int i = 0; i < NV; ++i) o[i] = f32x16{};
    float mrun = -1e30f, lrun = 0.f;
    WAIT_BAR0();
    for (int t = 0; t < NT; ++t) {
        const int st = t & 1;
        if (t + 1 < NT) DMA_TILE(t + 1, st ^ 1);
        const int jb = t - (NT - BAND);
        bool active = true;
        if (jb >= 0 && 64 * jb > 32 * wq + 31) active = false;
        bool selme = true;
        if (!DIFF && jb < 0) { selme = ((sel >> (t >> 2)) & 1u) != 0u; if (!__any(selme ? 1 : 0)) active = false; }
        if (active) {
            const lds_cptr kb = shm3 + st * STAGE + (DIFF ? comp * 8192 : 0) + hi * 1024 + r32 * 16;
            f32x16 p0 = f32x16{}, p1 = f32x16{};
#pragma unroll
            for (int d0 = 0; d0 < 4; ++d0) {
                const bf16x8 k0 = *(const LAS bf16x8*)(kb + d0 * 2048), k1 = *(const LAS bf16x8*)(kb + d0 * 2048 + 512);
                p0 = __builtin_amdgcn_mfma_f32_32x32x16_bf16(k0, qr[d0], p0, 0, 0, 0);
                p1 = __builtin_amdgcn_mfma_f32_32x32x16_bf16(k1, qr[d0], p1, 0, 0, 0);
            }
            if (jb >= 0) {
                const int kbase = 64 * t + 4 * hi;
#pragma unroll
                for (int r = 0; r < 16; ++r) { const int kv = kbase + (r & 3) + 8 * (r >> 2); if (kv > qpos) p0[r] = -INFINITY; if (kv + 32 > qpos) p1[r] = -INFINITY; }
            }
            if (!DIFF) { if (!selme) {
#pragma unroll
                for (int r = 0; r < 16; ++r) { p0[r] = -INFINITY; p1[r] = -INFINITY; } } }
            float rm = fmaxf(p0[0], p1[0]);
#pragma unroll
            for (int r = 1; r < 16; ++r) rm = fmaxf(rm, fmaxf(p0[r], p1[r]));
            rm = xmax(rm);
            if (__any(rm > mrun + 8.0f ? 1 : 0)) {
                const float mnew = fmaxf(mrun, rm), alpha = __builtin_amdgcn_exp2f(mrun - mnew);
                lrun *= alpha;
#pragma unroll
                for (int i = 0; i < NV; ++i)
#pragma unroll
                    for (int r = 0; r < 16; ++r) o[i][r] *= alpha;
                mrun = mnew;
            }
            float sacc = 0.f;
#pragma unroll
            for (int r = 0; r < 16; ++r) { p0[r] = __builtin_amdgcn_exp2f(p0[r] - mrun); p1[r] = __builtin_amdgcn_exp2f(p1[r] - mrun); sacc += p0[r] + p1[r]; }
            lrun += sacc;
            u32x4 pw[4];
#pragma unroll
            for (int i = 0; i < 4; ++i) { pw[0][i] = cvt_pk_bf16(p0[2 * i], p0[2 * i + 1]); pw[1][i] = cvt_pk_bf16(p0[8 + 2 * i], p0[8 + 2 * i + 1]);
                                          pw[2][i] = cvt_pk_bf16(p1[2 * i], p1[2 * i + 1]); pw[3][i] = cvt_pk_bf16(p1[8 + 2 * i], p1[8 + 2 * i + 1]); }
            const lds_cptr vb = shm3 + st * STAGE + VOFF + (4 * hi + ((lane & 15) >> 2)) * 64 + ((lane >> 4) & 1) * 32 + (lane & 3) * 8;
#pragma unroll
            for (int db = 0; db < NV; ++db)
#pragma unroll
                for (int ks = 0; ks < 4; ++ks) {
                    const int off = (db >> 1) * 8192 + (db & 1) * 4096 + ks * 1024;
                    const s16x4 lo = vtr(vb + off), hh = vtr(vb + off + 512);
                    const bf16x8 a = (bf16x8){lo[0], lo[1], lo[2], lo[3], hh[0], hh[1], hh[2], hh[3]};
                    o[db] = __builtin_amdgcn_mfma_f32_32x32x16_bf16(a, __builtin_bit_cast(bf16x8, pw[ks]), o[db], 0, 0, 0);
                }
        }
        WAIT_BAR0();
    }
#undef DMA_TILE
    const float inv = 1.0f / xsum(lrun);
    const size_t orow = ((size_t)b * SEQ + qpos) * DM;
    if (!DIFF) {
        float ss = 0.f;
#pragma unroll
        for (int db = 0; db < NV; ++db)
#pragma unroll
            for (int r = 0; r < 16; ++r) { o[db][r] *= inv; ss += o[db][r] * o[db][r]; }
        const float rn = 1.0f / sqrtf(xsum(ss) * (1.0f / 64.0f) + EPSN);
#pragma unroll
        for (int db = 0; db < NV; ++db)
#pragma unroll
            for (int g4 = 0; g4 < 4; ++g4) { const int d = 32 * db + 8 * g4 + 4 * hi; const f32x4 gn = *(const f32x4*)(gain + d);
                u32x2 wv; wv.x = cvt_pk_bf16(o[db][4 * g4] * rn * gn[0], o[db][4 * g4 + 1] * rn * gn[1]); wv.y = cvt_pk_bf16(o[db][4 * g4 + 2] * rn * gn[2], o[db][4 * g4 + 3] * rn * gn[3]);
                *(u32x2*)(Ob + orow + hx * 64 + d) = wv; }
    } else {
        LAS float* ex = (LAS float*)lds;
        if (comp == 1) {
#pragma unroll
            for (int db = 0; db < NV; ++db)
#pragma unroll
                for (int r = 0; r < 16; ++r) ex[(wq * 64 + db * 16 + r) * 64 + lane] = o[db][r] * inv;
        }
        WAIT_BAR0();
        if (comp == 0) {
            float ss = 0.f;
#pragma unroll
            for (int db = 0; db < NV; ++db)
#pragma unroll
                for (int r = 0; r < 16; ++r) { const float v = o[db][r] * inv - lam * ex[(wq * 64 + db * 16 + r) * 64 + lane]; o[db][r] = v; ss += v * v; }
            const float rn = oscale / sqrtf(xsum(ss) * (1.0f / 128.0f) + EPSN);
#pragma unroll
            for (int db = 0; db < NV; ++db)
#pragma unroll
                for (int g4 = 0; g4 < 4; ++g4) { const int d = 32 * db + 8 * g4 + 4 * hi; const f32x4 gn = *(const f32x4*)(gain + d);
                    u32x2 wv; wv.x = cvt_pk_bf16(o[db][4 * g4] * rn * gn[0], o[db][4 * g4 + 1] * rn * gn[1]); wv.y = cvt_pk_bf16(o[db][4 * g4 + 2] * rn * gn[2], o[db][4 * g4 + 3] * rn * gn[3]);
                    *(u32x2*)(Ob + orow + 512 + hx * 128 + d) = wv; }
        }
        WAIT_BAR0();
    }
}

#define XB_TMO      128
#define XB_XCNT(j)  (256  + 64 * (j))
#define XB_XSUB(j)  (1280 + 64 * (j))
#define XB_XGEN(j)  (2304 + 64 * (j))
#define XB_TOP      3328
#define XB_TOPGEN   3392
#define XCD_BAR_WORDS 3456
#define XB_SPIN_CAP (1u << 18)

__device__ __forceinline__ unsigned xb_ld(unsigned* p)              { return __hip_atomic_load(p, __ATOMIC_RELAXED, __HIP_MEMORY_SCOPE_AGENT); }
__device__ __forceinline__ unsigned xb_add(unsigned* p, unsigned v) { return __hip_atomic_fetch_add(p, v, __ATOMIC_RELAXED, __HIP_MEMORY_SCOPE_AGENT); }
__device__ __forceinline__ unsigned xb_xcc_id() { return (unsigned)__builtin_amdgcn_s_getreg((3 << 11) | 20) & 0xFu; }
#define XB_SPIN(cond, bar) do { unsigned _sp = 0; while (cond) { __builtin_amdgcn_s_sleep(1); \
    if ((++_sp & 255u) == 0u) { if (xb_ld(&(bar)[XB_TMO])) break; if (_sp > XB_SPIN_CAP) { atomicAdd(&(bar)[XB_TMO], 1u); break; } } } } while (0)

struct XcdBarrier {
    unsigned* bar; unsigned x;
    volatile LAS unsigned* st;
};

__device__ __forceinline__ XcdBarrier xcd_barrier_post(unsigned* bar, volatile LAS unsigned* st) {
    XcdBarrier b; b.bar = bar; b.x = xb_xcc_id(); b.st = st;
    if (threadIdx.x == 0) (void)xb_add(&bar[XB_XCNT(b.x)], 1u);
    return b;
}
__device__ __forceinline__ void xcd_barrier_complete(unsigned* bar, unsigned x, unsigned& nloc, unsigned& nx) {
    const unsigned G = gridDim.x * gridDim.y * gridDim.z;
    unsigned sum, cnt, mine, sp = 0u;
    for (;;) {
        sum = 0u; cnt = 0u; mine = 0u;
#pragma unroll
        for (unsigned j = 0; j < 16; ++j) { const unsigned c = xb_ld(&bar[XB_XCNT(j)]); sum += c; cnt += (c > 0u) ? 1u : 0u; mine = (j == x) ? c : mine; }
        if (sum == G) break;
        __builtin_amdgcn_s_sleep(1);
        if ((++sp & 255u) == 0u) { if (xb_ld(&bar[XB_TMO])) break; if (sp > XB_SPIN_CAP) { atomicAdd(&bar[XB_TMO], 1u); break; } }
    }
    nloc = mine > 0u ? mine : 1u; nx = cnt > 0u ? cnt : 1u;
}

__device__ __forceinline__ void xcd_barrier(const XcdBarrier& b) {
    asm volatile("s_waitcnt vmcnt(0)" ::: "memory");
    __syncthreads();
    if (threadIdx.x == 0) {
        unsigned* bar = b.bar;
        __builtin_amdgcn_s_waitcnt(0);
        unsigned nloc = b.st[0], nx = b.st[1];
        if (nloc == 0u) { xcd_barrier_complete(bar, b.x, nloc, nx); b.st[0] = nloc; b.st[1] = nx; }
        const unsigned old = xb_add(&bar[XB_XSUB(b.x)], 1u);
        const unsigned gen = old / nloc;
        if (old + 1u == (gen + 1u) * nloc) {
            __builtin_amdgcn_fence(__ATOMIC_RELEASE, "agent");
            asm volatile("s_waitcnt vmcnt(0)" ::: "memory");
            const unsigned og = xb_add(&bar[XB_TOP], 1u);
            const unsigned tg = og / nx;
            if (og + 1u == (tg + 1u) * nx) xb_add(&bar[XB_TOPGEN], 1u);
            else XB_SPIN(xb_ld(&bar[XB_TOPGEN]) == tg, bar);
            __builtin_amdgcn_fence(__ATOMIC_ACQUIRE, "agent");
            xb_add(&bar[XB_XGEN(b.x)], 1u);
            asm volatile("s_waitcnt vmcnt(0)" ::: "memory");
        } else {
            XB_SPIN(xb_ld(&bar[XB_XGEN(b.x)]) == gen, bar);
            __builtin_amdgcn_fence(__ATOMIC_ACQUIRE, "agent");
            asm volatile("s_waitcnt vmcnt(0)" ::: "memory");
        }
    }
    __syncthreads();
}

struct Args { const void* in[19]; float* out; unsigned char* ws; };
__device__ __forceinline__ const void* ldptr(const Args& a, int i) { asm volatile("" : "+s"(i)); return a.in[i]; }

__global__ void __launch_bounds__(512, 2) fwd_megakernel(Args a) {
    extern __shared__ __attribute__((aligned(16))) unsigned char lds_raw[];
    LAS unsigned char* lds = (LAS unsigned char*)lds_raw;
    cg::grid_group grid = cg::this_grid();
    const int tid = threadIdx.x, lane = tid & 63, wave = __builtin_amdgcn_readfirstlane(tid >> 6), G = gridDim.x;
#define INF(i) ((const float*)ldptr(a, (i)))
    unsigned char* ws = a.ws; float* out = a.out;
    for (int i = tid; i < 64; i += 512) ((LAS unsigned*)(lds + LDS_MISC))[i] = 0u;
    __syncthreads();
    XcdBarrier xbar = xcd_barrier_post((unsigned*)ws + CW_BAR, (volatile LAS unsigned*)(lds + LDS_MISC) + 8);
#define GRID_BAR() xcd_barrier(xbar)
    unsigned* ctl = (unsigned*)ws; float* kmean = (float*)(ws + CTL_KMEAN);
    float* mod = (float*)(ws + WS_MOD); float* gains = (float*)(ws + WS_GAINS); float* rope = (float*)(ws + WS_ROPE); float* part = (float*)(ws + WS_PART);
    bf16_t* XN = (bf16_t*)(ws + WS_XN); bf16_t* OB = (bf16_t*)(ws + WS_O); bf16_t* QKV = (bf16_t*)(ws + WS_QKV); bf16_t* HB = (bf16_t*)(ws + WS_H);

    {
        LAS float* scr = (LAS float*)(lds + wave * 16384);
        const int gw = blockIdx.x * 8 + wave, NGW = G * 8;
        constexpr int I_IN = 16 * 96, I_OUT = 16 * 32, I_G = 16 * 88, I_D = 44 * 32, I_L = I_IN + I_OUT + 2 * I_G + I_D;
        for (int it = gw; it < 2 * I_L; it += NGW) {
            const int l = it / I_L; int r = it % I_L; unsigned char* wl = ws + WS_W + (size_t)l * W_LSTRIDE;
            if (r < I_IN) { p0_transpose_item<1>(INF(6) + (size_t)l * DM * NIN, DM, NIN, (bf16_t*)(wl + W_IN), scr, r, lane); continue; } r -= I_IN;
            if (r < I_OUT) { p0_transpose_item<0>(INF(14) + (size_t)l * DM * DM, DM, DM, (bf16_t*)(wl + W_OUT), scr, r, lane); continue; } r -= I_OUT;
            if (r < I_G) { p0_transpose_item<2>(INF(16) + (size_t)l * DM * DFF, DM, DFF, (bf16_t*)(wl + W_GU), scr, r, lane); continue; } r -= I_G;
            if (r < I_G) { p0_transpose_item<3>(INF(17) + (size_t)l * DM * DFF, DM, DFF, (bf16_t*)(wl + W_GU), scr, r, lane); continue; } r -= I_G;
            p0_transpose_item<0>(INF(18) + (size_t)l * DFF * DM, DFF, DM, (bf16_t*)(wl + W_DN), scr, r, lane);
        }
        for (int it = gw; it < 2 * 16 * 96; it += NGW) {
            const int l = it / 1536, r = it % 1536, kc = r / 96, nb = r % 96;
            const float* cvec = INF(1); const float* W = INF(3) + (size_t)l * DM * NMOD + (size_t)(64 * kc) * NMOD + 64 * nb + lane;
            float sv[8], ac[8];
#pragma unroll
            for (int b = 0; b < 8; ++b) { const float cv = cvec[b * DM + 64 * kc + lane]; sv[b] = cv / (1.0f + __expf(-cv)); ac[b] = 0.f; }
#pragma unroll 8
            for (int i = 0; i < 64; ++i) { const float wv = W[(size_t)i * NMOD];
#pragma unroll
                for (int b = 0; b < 8; ++b) ac[b] += __uint_as_float(__builtin_amdgcn_readlane(__float_as_uint(sv[b]), i)) * wv; }
#pragma unroll
            for (int b = 0; b < 8; ++b) part[((size_t)(l * 16 + kc) * 8 + b) * NMOD + 64 * nb + lane] = ac[b];
        }
        if (blockIdx.x == 0 && tid < 128) { const int ll = tid >> 6, d = tid & 63; gains[ll * 256 + d] = INF(7)[tid]; gains[ll * 256 + 64 + d] = INF(8)[tid]; gains[ll * 256 + 128 + d] = INF(10)[tid]; gains[ll * 256 + 192 + d] = INF(11)[tid]; }
        for (int idx = blockIdx.x * 512 + tid; idx < MT * 8; idx += G * 512) {
            const int t = idx >> 3, i = idx & 7;
            const float invf = i == 0 ? 1.0f : i == 1 ? 0.19392274474868576f : i == 2 ? 0.03760603093086393f : i == 3 ? 0.007292664737217109f : i == 4 ? 0.001414213562373095f
                             : i == 5 ? 0.0002742481756762073f : i == 6 ? 5.318295896944988e-05f : 1.031338537721246e-05f;
            const float ang = (float)((const int*)ldptr(a, 2))[t] * invf;
            rope[(size_t)t * 16 + i] = cosf(ang); rope[(size_t)t * 16 + 8 + i] = sinf(ang);
        }
    }
    grid.sync();

#pragma nounroll
    for (int l = 0; l < 2; ++l) {
        unsigned char* wl = ws + WS_W + (size_t)l * W_LSTRIDE;
        const float* xcur = (l == 0) ? INF(0) : out;
        if (l == 0) { for (int idx = blockIdx.x * 512 + tid; idx < 2 * 8 * NMOD; idx += G * 512) { const int ll = idx / (8 * NMOD), r = idx % (8 * NMOD); mod[idx] = modsum(part, INF(4), ll, r / NMOD, r % NMOD); } }
        norm_phase(lds, xcur, INF(5) + l * DM, XN, mod, part, INF(4), l, 0, DM, l == 0);
        GRID_BAR();
        {
            pg8::Gemm g{XN, (const bf16_t*)(wl + W_IN), MT, NIN, DM}; pg8::StaticOrder S; S.init(MT, NIN, G, (int)blockIdx.x);
            EpiQKV E{QKV, gains + l * 256, rope, kmean + (size_t)l * 32768};
            pg8::gemm_phase<EpiQKV, pg8::StaticOrder, true, true>(lds, g, S, E);
        }
        GRID_BAR();
        {
            const float* lp = INF(12) + l * 256; float s1 = 0.f, s2 = 0.f;
            for (int i = 0; i < 64; ++i) { s1 += lp[i] * lp[64 + i]; s2 += lp[128 + i] * lp[192 + i]; }
            const float lam_init = (l == 0) ? 0.2f : 0.35550906759096934f;
            const float lam = expf(s1) - expf(s2) + lam_init;
            volatile LAS unsigned* qw = (volatile LAS unsigned*)(lds + LDS_MISC);
            for (;;) {
                if (tid == 0) qw[0] = atomicAdd(ctl + 64 * l, 1u);
                __syncthreads();
                const int idx = (int)qw[0];
                __syncthreads();
                if (idx >= 1024) break;
                constexpr unsigned CTM = 0xab5abfu;
                constexpr unsigned long long CQL = 0x3546758697abcdefull  , CQH = 0x112234ull  ;
                int start = 0, ty = 0, qb = 0, j = 0;
#pragma unroll
                for (int c = 0; c < 24; ++c) { const int tc = (CTM >> c) & 1u, cnt = tc ? 32 : 64; const int qc = (int)(((c < 16) ? (CQL >> (4 * c)) : (CQH >> (4 * (c - 16)))) & 15ull);
                    if (idx >= start && idx < start + cnt) { ty = tc; qb = qc; j = idx - start; } start += cnt; }
                if (ty) attn_unit<true>(lds, QKV, OB, j >> 2, j & 3, qb, nullptr, INF(13) + l * 128, lam, 1.0f - lam_init);
                else attn_unit<false>(lds, QKV, OB, j >> 3, j & 7, qb, kmean + (size_t)l * 32768 + (size_t)j * 512, INF(9) + l * 64, 0.f, 1.f);
            }
        }
        GRID_BAR();
        {
            pg8::Gemm g{OB, (const bf16_t*)(wl + W_OUT), MT, DM, DM}; pg8::StaticOrder S; S.init(MT, DM, G, (int)blockIdx.x);
            EpiRes E{(l == 0) ? INF(0) : out, out, mod + (size_t)l * 8 * NMOD + 2 * DM};
            pg8::gemm_phase<EpiRes, pg8::StaticOrder, true, true>(lds, g, S, E);
        }
        GRID_BAR();
        norm_phase(lds, out, INF(15) + l * DM, XN, mod, part, INF(4), l, 3 * DM, 4 * DM, false);
        GRID_BAR();
        {
            pg8::Gemm g{XN, (const bf16_t*)(wl + W_GU), MT, NGU, DM}; pg8::StaticOrder S; S.init(MT, NGU, G, (int)blockIdx.x);
            EpiSwiGLU E{HB};
            pg8::gemm_phase<EpiSwiGLU, pg8::StaticOrder, true, true>(lds, g, S, E);
        }
        GRID_BAR();
        {
            pg8::Gemm g{HB, (const bf16_t*)(wl + W_DN), MT, DM, DFF}; pg8::StaticOrder S; S.init(MT, DM, G, (int)blockIdx.x);
            EpiRes E{out, out, mod + (size_t)l * 8 * NMOD + 5 * DM};
            pg8::gemm_phase<EpiRes, pg8::StaticOrder, true, true>(lds, g, S, E);
        }
        if (l == 0) GRID_BAR();
    }
}

extern "C" void kernel_launch(void* const* d_in, const int* in_sizes, int n_in, void* d_out, int out_size, void* d_ws, size_t ws_size, hipStream_t stream) {
    static int grid = 0;
    if (grid == 0) {
        if (n_in != 19 || out_size != MT * DM || ws_size < WS_END) { fprintf(stderr, "kernel_launch: unexpected problem (n_in %d out %d ws %zu); nothing launched\n", n_in, out_size, ws_size); grid = -1; return; }
        int dev = 0, cus = 0, per_cu = 0;
        if (hipGetDevice(&dev) != hipSuccess || hipDeviceGetAttribute(&cus, hipDeviceAttributeMultiprocessorCount, dev) != hipSuccess) { grid = -1; return; }
        if (hipFuncSetAttribute((const void*)fwd_megakernel, hipFuncAttributeMaxDynamicSharedMemorySize, LDS_BYTES) != hipSuccess) { fprintf(stderr, "kernel_launch: hipFuncSetAttribute failed\n"); grid = -1; return; }
        if (hipOccupancyMaxActiveBlocksPerMultiprocessor(&per_cu, (const void*)fwd_megakernel, 512, LDS_BYTES) != hipSuccess || per_cu < 1) { fprintf(stderr, "kernel_launch: occupancy query gave %d\n", per_cu); per_cu = 1; }
        (void)hipGetLastError();
        grid = cus * per_cu;
        fprintf(stderr, "kernel_launch: grid %d (cus %d x %d)\n", grid, cus, per_cu);
    }
    if (grid < 0) return;
    if (hipMemsetAsync(d_ws, 0, CTL_ZERO_BYTES, stream) != hipSuccess) { fprintf(stderr, "kernel_launch: memset failed\n"); return; }
    Args a{};
    for (int i = 0; i < 19; ++i) a.in[i] = d_in[i];
    a.out = (float*)d_out; a.ws = (unsigned char*)d_ws;
    void* args[] = {&a};
    hipError_t e = hipLaunchCooperativeKernel((const void*)fwd_megakernel, dim3(grid), dim3(512), args, LDS_BYTES, stream);
    if (e != hipSuccess) fprintf(stderr, "kernel_launch: cooperative launch failed: %s (grid %d)\n", hipGetErrorString(e), grid);
}
```
